# Optimizing an MI355X kernel written in HIP

```python
import math
import jax, jax.numpy as jnp
from jax import lax
import numpy as np

D_MODEL = 2048
BATCH = 1
SEQ = 8192
DEPTH = 1

SSM_WIDTH = D_MODEL // 2
SSM_GROUP = 16
SSM_GROUPS = SSM_WIDTH // SSM_GROUP
SSM_STATE = 64
DT_MIN = 1e-3
DT_MAX = 1e-1
HEAD_DIM = 64
N_Q_HEADS = (D_MODEL // 2) // HEAD_DIM
N_KV_HEADS = 4
Q_PER_KV = N_Q_HEADS // N_KV_HEADS
WINDOW = 128
ROPE_DIM = HEAD_DIM // 4
ROPE_THETA = 500000.0
Q_WIDTH = N_Q_HEADS * HEAD_DIM
KV_WIDTH = N_KV_HEADS * HEAD_DIM
N_BRANCH = 2
IN_WIDTH = SSM_WIDTH + Q_WIDTH + 2 * KV_WIDTH + N_BRANCH * D_MODEL
N_GROUPS = 8
EXPERTS_PER_GROUP = 8
N_EXPERTS = N_GROUPS * EXPERTS_PER_GROUP
TOP_K = 2
D_EXPERT = D_MODEL // 4
MOE_BLOCK = 128
EPS = 1e-6

kernel_name = "hybrid_s5_swa_sink_hiermoe"


def rmsnorm(x, g):
    xf = x.astype(jnp.float32)
    y = xf * lax.rsqrt(jnp.mean(xf * xf, axis=-1, keepdims=True) + EPS)
    return (y * g.astype(jnp.float32)).astype(x.dtype)


def partial_rope(x, positions):
    half = ROPE_DIM // 2
    inv_freq = ROPE_THETA ** (-jnp.arange(half, dtype=jnp.float32) / half)
    ang = positions.astype(jnp.float32)[..., None] * inv_freq
    cos = jnp.cos(ang)[:, :, None, :]
    sin = jnp.sin(ang)[:, :, None, :]
    xr = x[..., :ROPE_DIM].astype(jnp.float32)
    x1, x2 = xr[..., :half], xr[..., half:]
    rot = jnp.concatenate([x1 * cos - x2 * sin, x2 * cos + x1 * sin], axis=-1)
    return jnp.concatenate([rot.astype(x.dtype), x[..., ROPE_DIM:]], axis=-1)


def s5_ssm(u, a_re, a_im, log_dt, b_re, b_im, c_re, c_im, d_skip):
    f32 = jnp.float32
    u = u.astype(f32)
    lam_re = jnp.minimum(a_re.astype(f32), -1e-4)
    lam_im = a_im.astype(f32)
    dt = jnp.exp(log_dt.astype(f32))[:, None]
    mag = jnp.exp(lam_re * dt)
    abar_re = mag * jnp.cos(lam_im * dt)
    abar_im = mag * jnp.sin(lam_im * dt)
    den = lam_re * lam_re + lam_im * lam_im
    nr = abar_re - 1.0
    ni = abar_im
    coef_re = (nr * lam_re + ni * lam_im) / den
    coef_im = (ni * lam_re - nr * lam_im) / den
    br = b_re.astype(f32)
    bi = b_im.astype(f32)
    bbar_re = coef_re[..., None] * br - coef_im[..., None] * bi
    bbar_im = coef_re[..., None] * bi + coef_im[..., None] * br
    bu_re = jnp.einsum('bsgc,gpc->bsgp', u, bbar_re)
    bu_im = jnp.einsum('bsgc,gpc->bsgp', u, bbar_im)
    ar = jnp.broadcast_to(abar_re, bu_re.shape)
    ai = jnp.broadcast_to(abar_im, bu_re.shape)

    def combine(lhs, rhs):
        a1r, a1i, b1r, b1i = lhs
        a2r, a2i, b2r, b2i = rhs
        return (a2r * a1r - a2i * a1i,
                a2r * a1i + a2i * a1r,
                a2r * b1r - a2i * b1i + b2r,
                a2r * b1i + a2i * b1r + b2i)

    _, _, xr, xi = lax.associative_scan(combine, (ar, ai, bu_re, bu_im), axis=1)
    y = (jnp.einsum('bsgp,gcp->bsgc', xr, c_re.astype(f32))
         - jnp.einsum('bsgp,gcp->bsgc', xi, c_im.astype(f32))
         + d_skip.astype(f32) * u)
    return y


def sliding_window_attention(q, k, v, sinks):
    f32 = jnp.float32
    bsz, seq = q.shape[0], q.shape[1]
    nb = seq // WINDOW
    qb = q.astype(f32).reshape(bsz, nb, WINDOW, N_KV_HEADS, Q_PER_KV, HEAD_DIM)
    pad = jnp.zeros((bsz, WINDOW, N_KV_HEADS, HEAD_DIM), f32)

    def band(t):
        t = t.astype(f32)
        prev = jnp.concatenate([pad, t], axis=1)[:, :seq].reshape(bsz, nb, WINDOW, N_KV_HEADS, HEAD_DIM)
        cur = t.reshape(bsz, nb, WINDOW, N_KV_HEADS, HEAD_DIM)
        return jnp.concatenate([prev, cur], axis=2)

    kb = band(k)
    vb = band(v)
    scores = jnp.einsum('bnqhgd,bnkhd->bnhgqk', qb, kb) * (HEAD_DIM ** -0.5)
    qi = jnp.arange(WINDOW)[:, None]
    kj = jnp.arange(2 * WINDOW)[None, :]
    dist = qi + WINDOW - kj
    in_band = (dist >= 0) & (dist < WINDOW)
    not_pad = (jnp.arange(nb)[:, None, None] > 0) | (kj[None] >= WINDOW)
    mask = in_band[None] & not_pad
    scores = jnp.where(mask[None, :, None, None], scores, -jnp.inf)
    sink = sinks.astype(f32).reshape(N_KV_HEADS, Q_PER_KV)[None, None, :, :, None, None]
    m = jnp.maximum(jnp.max(scores, axis=-1, keepdims=True), sink)
    p = jnp.exp(scores - m)
    probs = p / (jnp.sum(p, axis=-1, keepdims=True) + jnp.exp(sink - m))
    out = jnp.einsum('bnhgqk,bnkhd->bnqhgd', probs, vb)
    return out.reshape(bsz, seq, Q_WIDTH)


def hierarchical_moe(x, w_rg, b_rg, w_re, b_re, w_gate, w_up, w_down):
    bsz, seq, d = x.shape
    n_tok = bsz * seq
    xf = x.reshape(n_tok, d)
    lg = (xf @ w_rg + b_rg).astype(jnp.float32)
    pg = jax.nn.softmax(lg, axis=-1)
    grp = jnp.argmax(lg, axis=-1)
    p_grp = jnp.take_along_axis(pg, grp[:, None], axis=-1)
    le = (xf @ w_re + b_re).astype(jnp.float32).reshape(n_tok, N_GROUPS, EXPERTS_PER_GROUP)
    le_g = jnp.take_along_axis(le, grp[:, None, None], axis=1)[:, 0]
    top_l, top_i = lax.top_k(le_g, TOP_K)
    wts = jax.nn.softmax(top_l, axis=-1) * p_grp
    eid = grp[:, None] * EXPERTS_PER_GROUP + top_i
    n_assign = n_tok * TOP_K
    e_flat = eid.reshape(n_assign)
    w_flat = wts.reshape(n_assign)
    tok_flat = jnp.repeat(jnp.arange(n_tok, dtype=jnp.int32), TOP_K)
    order = jnp.argsort(e_flat)
    e_sorted = e_flat[order]
    counts = jnp.bincount(e_flat, length=N_EXPERTS)
    starts = jnp.cumsum(counts) - counts
    padded = ((counts + MOE_BLOCK - 1) // MOE_BLOCK) * MOE_BLOCK
    pad_end = jnp.cumsum(padded)
    pad_start = pad_end - padded
    dest = pad_start[e_sorted] + (jnp.arange(n_assign) - starts[e_sorted])
    n_blocks = -(-(n_assign + N_EXPERTS * (MOE_BLOCK - 1)) // MOE_BLOCK)
    n_rows = n_blocks * MOE_BLOCK
    row_tok = jnp.zeros((n_rows,), jnp.int32).at[dest].set(tok_flat[order])
    row_w = jnp.zeros((n_rows,), jnp.float32).at[dest].set(w_flat[order])
    blk_exp = jnp.minimum(jnp.searchsorted(pad_end, jnp.arange(n_blocks) * MOE_BLOCK, side='right'),
                          N_EXPERTS - 1)
    xs = xf[row_tok].reshape(n_blocks, MOE_BLOCK, d)

    def expert_block(args):
        xb, e = args
        hdn = jax.nn.silu(xb @ w_gate[e]) * (xb @ w_up[e])
        return hdn @ w_down[e]

    ys = lax.map(expert_block, (xs, blk_exp)).reshape(n_rows, d)
    out = jax.ops.segment_sum(ys * row_w[:, None].astype(ys.dtype), row_tok, num_segments=n_tok)
    return out.reshape(bsz, seq, d)


def setup_inputs(seed: int = 0) -> dict:
    key = jax.random.key(seed)
    ks = jax.random.split(key, 32)
    f32 = jnp.float32
    L = DEPTH

    def nrm(k, shape, scale):
        return jax.random.normal(k, shape, f32) * scale

    x = jax.random.normal(ks[0], (BATCH, SEQ, D_MODEL), f32)
    positions = jnp.broadcast_to(jnp.arange(SEQ, dtype=jnp.int32)[None, :], (BATCH, SEQ))
    n_idx = jnp.arange(SSM_STATE, dtype=f32)
    return {
        "x": x,
        "positions": positions,
        "norm_mix_g": 1.0 + nrm(ks[1], (L, D_MODEL), 0.02),
        "w_in": nrm(ks[2], (L, D_MODEL, IN_WIDTH), D_MODEL ** -0.5),
        "b_in": nrm(ks[3], (L, IN_WIDTH), 0.02),
        "ssm_a_re": -0.5 + nrm(ks[4], (L, SSM_GROUPS, SSM_STATE), 0.01),
        "ssm_a_im": math.pi * n_idx + nrm(ks[5], (L, SSM_GROUPS, SSM_STATE), 0.01),
        "ssm_log_dt": jax.random.uniform(ks[6], (L, SSM_GROUPS), f32, math.log(DT_MIN), math.log(DT_MAX)),
        "ssm_b_re": nrm(ks[7], (L, SSM_GROUPS, SSM_STATE, SSM_GROUP), (2 * SSM_GROUP) ** -0.5),
        "ssm_b_im": nrm(ks[8], (L, SSM_GROUPS, SSM_STATE, SSM_GROUP), (2 * SSM_GROUP) ** -0.5),
        "ssm_c_re": nrm(ks[9], (L, SSM_GROUPS, SSM_GROUP, SSM_STATE), (2 * SSM_STATE) ** -0.5),
        "ssm_c_im": nrm(ks[10], (L, SSM_GROUPS, SSM_GROUP, SSM_STATE), (2 * SSM_STATE) ** -0.5),
        "ssm_d": nrm(ks[11], (L, SSM_GROUPS, SSM_GROUP), 1.0),
        "w_glu": nrm(ks[12], (L, SSM_WIDTH, 2 * SSM_WIDTH), SSM_WIDTH ** -0.5),
        "b_glu": nrm(ks[13], (L, 2 * SSM_WIDTH), 0.02),
        "w_br_ssm": nrm(ks[14], (L, SSM_WIDTH, D_MODEL), SSM_WIDTH ** -0.5),
        "attn_sinks": nrm(ks[15], (L, N_Q_HEADS), 1.0),
        "w_br_attn": nrm(ks[16], (L, Q_WIDTH, D_MODEL), Q_WIDTH ** -0.5),
        "w_o": nrm(ks[17], (L, D_MODEL, D_MODEL), D_MODEL ** -0.5),
        "norm_ffn_g": 1.0 + nrm(ks[18], (L, D_MODEL), 0.02),
        "w_router_group": nrm(ks[19], (L, D_MODEL, N_GROUPS), D_MODEL ** -0.5),
        "b_router_group": nrm(ks[20], (L, N_GROUPS), 0.01),
        "w_router_expert": nrm(ks[21], (L, D_MODEL, N_EXPERTS), D_MODEL ** -0.5),
        "b_router_expert": nrm(ks[22], (L, N_EXPERTS), 0.01),
        "w_exp_gate": nrm(ks[23], (L, N_EXPERTS, D_MODEL, D_EXPERT), D_MODEL ** -0.5),
        "w_exp_up": nrm(ks[24], (L, N_EXPERTS, D_MODEL, D_EXPERT), D_MODEL ** -0.5),
        "w_exp_down": nrm(ks[25], (L, N_EXPERTS, D_EXPERT, D_MODEL), D_EXPERT ** -0.5),
        "norm_final_g": 1.0 + nrm(ks[26], (D_MODEL,), 0.02),
    }


def reference(x, positions, norm_mix_g, w_in, b_in, ssm_a_re, ssm_a_im, ssm_log_dt,
              ssm_b_re, ssm_b_im, ssm_c_re, ssm_c_im, ssm_d, w_glu, b_glu, w_br_ssm,
              attn_sinks, w_br_attn, w_o, norm_ffn_g, w_router_group, b_router_group,
              w_router_expert, b_router_expert, w_exp_gate, w_exp_up, w_exp_down, norm_final_g):
    bsz, seq = x.shape[0], x.shape[1]
    splits = [SSM_WIDTH, SSM_WIDTH + Q_WIDTH, SSM_WIDTH + Q_WIDTH + KV_WIDTH,
              SSM_WIDTH + Q_WIDTH + 2 * KV_WIDTH]
    h = x
    for l in range(DEPTH):
        xn = rmsnorm(h, norm_mix_g[l])
        proj = xn @ w_in[l] + b_in[l]
        u, q, k, v, gl = jnp.split(proj, splits, axis=-1)
        y = s5_ssm(u.reshape(bsz, seq, SSM_GROUPS, SSM_GROUP), ssm_a_re[l], ssm_a_im[l],
                   ssm_log_dt[l], ssm_b_re[l], ssm_b_im[l], ssm_c_re[l], ssm_c_im[l], ssm_d[l])
        z = jax.nn.gelu(y.reshape(bsz, seq, SSM_WIDTH)).astype(x.dtype)
        ga, gb = jnp.split(z @ w_glu[l] + b_glu[l], 2, axis=-1)
        y_ssm = (ga * jax.nn.sigmoid(gb)) @ w_br_ssm[l]
        qh = partial_rope(q.reshape(bsz, seq, N_Q_HEADS, HEAD_DIM), positions)
        kh = partial_rope(k.reshape(bsz, seq, N_KV_HEADS, HEAD_DIM), positions)
        vh = v.reshape(bsz, seq, N_KV_HEADS, HEAD_DIM)
        o = sliding_window_attention(qh, kh, vh, attn_sinks[l]).astype(x.dtype)
        y_attn = o @ w_br_attn[l]
        gates = jax.nn.sigmoid(gl.reshape(bsz, seq, N_BRANCH, D_MODEL))
        mixed = gates[:, :, 0, :] * y_ssm + gates[:, :, 1, :] * y_attn
        h = h + mixed @ w_o[l]
        hn = rmsnorm(h, norm_ffn_g[l])
        h = h + hierarchical_moe(hn, w_router_group[l], b_router_group[l], w_router_expert[l],
                                 b_router_expert[l], w_exp_gate[l], w_exp_up[l], w_exp_down[l])
    return rmsnorm(h, norm_final_g)
```

```cpp
#include <hip/hip_runtime.h>
#include <cstdio>
#include <cstdint>

#define LAS __attribute__((address_space(3)))
#define GAS __attribute__((address_space(1)))
typedef unsigned short bf16;
typedef short bf16x8 __attribute__((ext_vector_type(8)));
typedef float f32x2 __attribute__((ext_vector_type(2)));
typedef float f32x4 __attribute__((ext_vector_type(4)));
typedef float f32x16 __attribute__((ext_vector_type(16)));
typedef unsigned u32x2 __attribute__((ext_vector_type(2)));
typedef unsigned u32x4 __attribute__((ext_vector_type(4)));
typedef __bf16 bf16x2n __attribute__((ext_vector_type(2)));

#ifndef MK_N_LAUNCHES
#define MK_N_LAUNCHES 1
#endif
constexpr int N_PHASES = 11;
#ifndef PHMASK
#define PHMASK 0x7ff
#endif
#ifndef PROBE_PH
#define PROBE_PH -1
#endif
#define REP(k) for (int rep_ = 0; rep_ < ((k) == PROBE_PH ? 2 : 1); ++rep_)
constexpr int N_LAUNCHES = MK_N_LAUNCHES;
constexpr int NWAVES = 8;

constexpr int T = 8192, D = 2048, INW = 6656;
constexpr int SSMW = 1024, SGRP = 64, SCH = 16, SST = 64;
constexpr int NQH = 16, NKVH = 4, HD = 64;
constexpr int NEXP = 64, DE = 512;
constexpr int LSEG = 128, NSEG = T / LSEG;
constexpr float EPS = 1e-6f;
constexpr int LIST_CAP = 8192;

constexpr size_t MiB = 1u << 20;
constexpr size_t WS_CTL = 0, CTL_ZERO_BYTES = 1 * MiB;
constexpr size_t WS_TAB = 1 * MiB;
constexpr size_t TAB_ABAR = 0, TAB_ABARL = 32768, TAB_BB = 65536, TAB_CM = 65536 + 262144;
constexpr size_t WS_E = 2 * MiB;
constexpr size_t WS_WIN = 4 * MiB;
constexpr size_t WS_WGLU = 30 * MiB;
constexpr size_t WS_WBRS = 34 * MiB;
constexpr size_t WS_WBRA = 38 * MiB;
constexpr size_t WS_WO = 42 * MiB;
constexpr size_t WS_XN = 50 * MiB;
constexpr size_t WS_U = 82 * MiB;
constexpr size_t WS_Q = 98 * MiB;
constexpr size_t WS_K = 114 * MiB;
constexpr size_t WS_VT = 118 * MiB;
constexpr size_t WS_GATES = 122 * MiB;
constexpr size_t WS_Z = 186 * MiB;
constexpr size_t WS_G = 202 * MiB;
constexpr size_t WS_O = 218 * MiB;
constexpr size_t WS_MIX = 234 * MiB;
constexpr size_t WS_H1 = 266 * MiB;
constexpr size_t WS_HN = 330 * MiB;
constexpr size_t WS_LISTA = 362 * MiB;
constexpr size_t WS_LISTW = 364 * MiB;
constexpr size_t WS_Y2 = 366 * MiB;
constexpr size_t WS_HB = 430 * MiB;
constexpr size_t WS_WR = 472 * MiB;
constexpr size_t WS_END = 504 * MiB;
constexpr int CW_BAR = 4096;
constexpr int CW_CNT = 16384;

constexpr int LDS_BYTES = 163840;
constexpr int MISC_OFF = LDS_BYTES - 1024;

#define LDS_WAIT() asm volatile("s_waitcnt lgkmcnt(0)" ::: "memory")
#define MFMA_SETTLE() do { __builtin_amdgcn_sched_barrier(0); asm volatile("s_nop 15\n\ts_nop 15\n\ts_nop 15\n\ts_nop 15" ::: "memory"); __builtin_amdgcn_sched_barrier(0); } while (0)
#define VM_WAIT() asm volatile("s_waitcnt vmcnt(0)" ::: "memory")
__device__ __forceinline__ unsigned pk2(float lo, float hi) { f32x2 v = {lo, hi}; return __builtin_bit_cast(unsigned, __builtin_convertvector(v, bf16x2n)); }
__device__ __forceinline__ float bf_lo(unsigned u) { return __builtin_bit_cast(float, u << 16); }
__device__ __forceinline__ float bf_hi(unsigned u) { return __builtin_bit_cast(float, u & 0xffff0000u); }
__device__ __forceinline__ float wave_sum(float v) {
#pragma unroll
    for (int o = 1; o < 64; o <<= 1) v += __shfl_xor(v, o);
    return v;
}
__device__ __forceinline__ float fast_exp(float x) { return __builtin_amdgcn_exp2f(x * 1.4426950408889634f); }
__device__ __forceinline__ float sigmoidf_(float x) { return __builtin_amdgcn_rcpf(1.0f + fast_exp(-x)); }

namespace pg8 {
constexpr int BM = 256, BK = 64, HALF = 128, HTB = HALF * BK * 2, STAGE_BYTES = 8 * HTB, NXCD = 8, WGM = 8;
__host__ __device__ __forceinline__ int lds_byte(int r, int c) { const int st = (r >> 4) * 2 + (c >> 5), rr = r & 15, cc = c & 31, ob = rr * 64 + cc * 2; return st * 1024 + (ob ^ (((ob >> 9) & 1) << 5)); }
__host__ __device__ __forceinline__ void stage_rc(int b, int& R, int& C) { const int st = b / 1024, sb = b % 1024, swz = sb ^ (((sb >> 9) & 1) << 5); R = (st >> 1) * 16 + swz / 64; C = (st & 1) * 32 + (swz % 64) / 2; }
__host__ __device__ __forceinline__ int perm32(int rho) { const int n = rho >> 4, i = rho & 15; return 8 * (i >> 2) + 4 * n + (i & 3); }

struct Unit { int pm, pn, aux, aux2; const char* a; const char* b; };

__device__ __forceinline__ void grid_order(int L, int nM, int nN, int& pm, int& pn) {
    const int nwg = nM * nN; int wgid = L;
    { const int q = nwg / NXCD, r = nwg % NXCD, xcd = wgid % NXCD, off = wgid / NXCD; wgid = (xcd < r ? xcd * (q + 1) : r * (q + 1) + (xcd - r) * q) + off; }
    const int nig = WGM * nN, gid = wgid / nig, fm = gid * WGM, gsz = (nM - fm) < WGM ? (nM - fm) : WGM;
    pm = fm + ((wgid % nig) % gsz); pn = (wgid % nig) / gsz;
}
__device__ __forceinline__ int xcd_remap(int L, int nwg) { const int q = nwg / NXCD, r = nwg % NXCD, xcd = L % NXCD, off = L / NXCD; return (xcd < r ? xcd * (q + 1) : r * (q + 1) + (xcd - r) * q) + off; }

template <class Epi, class Sched, bool ALIGN_EPI, bool SP2, bool GATHER>
__device__ __forceinline__ void gemm_phase(LAS unsigned char* lds, const int K, const Sched& S, const Epi& E) {
    const int tid = threadIdx.x, wid = __builtin_amdgcn_readfirstlane(tid >> 6), lane = tid & 63, wr = wid >> 2, wc = wid & 3, fr = lane & 15, fq = lane >> 4;
    const int nt = K / BK;
    unsigned voffA[2], voffB[2]; int RA[2], CA[2];
#pragma unroll
    for (int i = 0; i < 2; ++i) { int R, C; stage_rc(tid * 16 + i * 8192, R, C); const int Rb = Epi::PERM ? ((R & ~31) + perm32(R & 31)) : R;
        RA[i] = R; CA[i] = C; voffA[i] = (unsigned)(R * K + C) * 2u; voffB[i] = (unsigned)(Rb * K + C) * 2u; }
    const size_t kstep = (size_t)(BK * 2);
    const size_t hstep = (size_t)HALF * K * 2;
    const unsigned ldsw = (unsigned)wid * 1024u;
    const int aoff = lds_byte(wr * 64 + fr, fq * 8), boff = lds_byte(wc * 32 + fr, fq * 8);
    unsigned gC[2][2], gN[2][2];
#define PG8_SA(b, h) (((b) * 2 + (h)) * HTB)
#define PG8_SB(b, h) ((4 + (b) * 2 + (h)) * HTB)
#define PG8_GLDS(src, dstoff) __builtin_amdgcn_global_load_lds((const unsigned*)(src), (LAS unsigned*)(lds + (dstoff)), 16, 0, 0)
#define PG8_STAGE_B(bufoff, gbase) do { PG8_GLDS((const char*)(gbase) + voffB[0], (bufoff) + ldsw); PG8_GLDS((const char*)(gbase) + voffB[1], (bufoff) + ldsw + 8192); } while (0)
#define PG8_STAGE_A(bufoff, gbase, h, usen) do { if constexpr (GATHER) { const unsigned o0_ = (usen) ? gN[h][0] : gC[h][0], o1_ = (usen) ? gN[h][1] : gC[h][1]; \
            PG8_GLDS((const char*)(gbase) + o0_, (bufoff) + ldsw); PG8_GLDS((const char*)(gbase) + o1_, (bufoff) + ldsw + 8192); } \
        else { PG8_GLDS((const char*)(gbase) + (h) * hstep + voffA[0], (bufoff) + ldsw); PG8_GLDS((const char*)(gbase) + (h) * hstep + voffA[1], (bufoff) + ldsw + 8192); } } while (0)
#define PG8_LDA(dst, b, h) do { _Pragma("unroll") for (int m = 0; m < 4; ++m) _Pragma("unroll") for (int k = 0; k < 2; ++k) dst[m][k] = *(const LAS bf16x8*)(lds + PG8_SA(b, h) + aoff + m * 2048 + k * 1024); } while (0)
#define PG8_LDB(dst, b, h) do { _Pragma("unroll") for (int n = 0; n < 2; ++n) _Pragma("unroll") for (int k = 0; k < 2; ++k) dst[n][k] = *(const LAS bf16x8*)(lds + PG8_SB(b, h) + boff + n * 2048 + k * 1024); } while (0)
#define PG8_MMA(ai, bj, At, Bt) do { __builtin_amdgcn_s_setprio(1); _Pragma("unroll") for (int m = 0; m < 4; ++m) _Pragma("unroll") for (int n = 0; n < 2; ++n) _Pragma("unroll") for (int k = 0; k < 2; ++k) \
        acc[ai][bj][m][n] = __builtin_amdgcn_mfma_f32_16x16x32_bf16(Bt[n][k], At[m][k], acc[ai][bj][m][n], 0, 0, 0); __builtin_amdgcn_s_setprio(0); } while (0)
#define PG8_WAIT_V(n) asm volatile("s_waitcnt vmcnt(" #n ")" ::: "memory")
#define PG8_WAIT_L(n) asm volatile("s_waitcnt lgkmcnt(" #n ")" ::: "memory")
#define PG8_BAR __builtin_amdgcn_s_barrier()
#define PG8_SCHED __builtin_amdgcn_sched_barrier(0)
    Unit cur, nxt; int ui = 0;
    if (!S.next(0, cur)) return;
    if constexpr (GATHER) S.gather(cur, gC, RA, CA);
    f32x4 acc[2][2][4][2];
#pragma unroll
    for (int a = 0; a < 2; ++a)
#pragma unroll
        for (int b = 0; b < 2; ++b)
#pragma unroll
            for (int m = 0; m < 4; ++m)
#pragma unroll
                for (int n = 0; n < 2; ++n) acc[a][b][m][n] = (f32x4){0.f, 0.f, 0.f, 0.f};
    bf16x8 At[4][2], B0[2][2], B1[2][2];
    const char* cA = cur.a; const char* cB = cur.b;
    static_assert(SP2, "only the two-super-phase loop is kept");
    PG8_STAGE_B(PG8_SB(0, 0), cB); PG8_STAGE_B(PG8_SB(0, 1), cB + hstep); PG8_STAGE_A(PG8_SA(0, 0), cA, 0, false); PG8_STAGE_A(PG8_SA(0, 1), cA, 1, false);
    if (wr == 1) PG8_BAR;
    PG8_WAIT_V(2); PG8_BAR;
    PG8_STAGE_B(PG8_SB(1, 0), cB + kstep); PG8_STAGE_A(PG8_SA(1, 0), cA + kstep, 0, false); PG8_STAGE_B(PG8_SB(1, 1), cB + hstep + kstep);
    PG8_WAIT_V(6); PG8_BAR;
    for (;;) {
        const bool has_next = S.next(ui + 1, nxt);
        if constexpr (GATHER) { if (has_next) S.gather(nxt, gN, RA, CA); else {
#pragma unroll
            for (int h = 0; h < 2; ++h) { gN[h][0] = gC[h][0]; gN[h][1] = gC[h][1]; } } }
        const char* nA = has_next ? nxt.a : cA; const char* nB = has_next ? nxt.b : cB;
        for (int t = 0; t < nt; t += 2) {
            const bool last = (t == nt - 2);
            const char* a1 = cA + (size_t)(t + 1) * kstep;
            const char* a2 = last ? nA : cA + (size_t)(t + 2) * kstep; const char* b2 = last ? nB : cB + (size_t)(t + 2) * kstep;
            const char* a3 = a2 + kstep; const char* b3 = b2 + kstep;
            PG8_LDB(B0, 0, 0); PG8_LDB(B1, 0, 1); PG8_SCHED; PG8_LDA(At, 0, 0); PG8_STAGE_A(PG8_SA(1, 1), a1, 1, false);
            PG8_WAIT_V(8); PG8_WAIT_L(0); PG8_BAR; PG8_MMA(0, 0, At, B0); PG8_MMA(0, 1, At, B1); PG8_BAR; PG8_SCHED;
            PG8_LDA(At, 0, 1); PG8_STAGE_B(PG8_SB(0, 0), b2); PG8_STAGE_B(PG8_SB(0, 1), b2 + hstep); PG8_STAGE_A(PG8_SA(0, 0), a2, 0, last);
            PG8_WAIT_V(8); PG8_WAIT_L(0); PG8_BAR; PG8_MMA(1, 0, At, B0); PG8_MMA(1, 1, At, B1); PG8_BAR; PG8_SCHED;
            PG8_LDB(B0, 1, 0); PG8_LDB(B1, 1, 1); PG8_SCHED; PG8_LDA(At, 1, 0); PG8_STAGE_A(PG8_SA(0, 1), a2, 1, last);
            PG8_WAIT_V(8); PG8_WAIT_L(0); PG8_BAR; PG8_MMA(0, 0, At, B0); PG8_MMA(0, 1, At, B1); PG8_BAR; PG8_SCHED;
            PG8_LDA(At, 1, 1); PG8_STAGE_B(PG8_SB(1, 0), b3); PG8_STAGE_B(PG8_SB(1, 1), b3 + hstep); PG8_STAGE_A(PG8_SA(1, 0), a3, 0, last);
            PG8_WAIT_V(8); PG8_WAIT_L(0); PG8_BAR; PG8_MMA(1, 0, At, B0); PG8_MMA(1, 1, At, B1); PG8_BAR; PG8_SCHED;
        }
        if constexpr (ALIGN_EPI) { if (wr == 0) PG8_BAR; }
        MFMA_SETTLE();
        E(acc, cur, wr, wc, fr, fq);
        if (!has_next) break;
        if (!(Epi::KEEP && cur.aux == 0)) {
#pragma unroll
        for (int a = 0; a < 2; ++a)
#pragma unroll
            for (int b = 0; b < 2; ++b)
#pragma unroll
                for (int m = 0; m < 4; ++m)
#pragma unroll
                    for (int n = 0; n < 2; ++n) acc[a][b][m][n] = (f32x4){0.f, 0.f, 0.f, 0.f};
        }
        cur = nxt; cA = nA; cB = nB; ++ui;
        if constexpr (GATHER) {
#pragma unroll
            for (int h = 0; h < 2; ++h) { gC[h][0] = gN[h][0]; gC[h][1] = gN[h][1]; } }
        if constexpr (ALIGN_EPI) { if (wr == 1) PG8_BAR; }
    }
    PG8_WAIT_V(0);
    if constexpr (!ALIGN_EPI) { if (wr == 0) PG8_BAR; }
    PG8_BAR;
#undef PG8_SA
#undef PG8_SB
#undef PG8_GLDS
#undef PG8_STAGE_A
#undef PG8_STAGE_B
#undef PG8_LDA
#undef PG8_LDB
#undef PG8_MMA
#undef PG8_WAIT_V
#undef PG8_WAIT_L
#undef PG8_BAR
#undef PG8_SCHED
}
}

#define XB_TMO      128
#define XB_XCNT(j)  (256  + 64 * (j))
#define XB_XSUB(j)  (1280 + 64 * (j))
#define XB_XGEN(j)  (2304 + 64 * (j))
#define XB_TOP      3328
#define XB_TOPGEN   3392
#define XCD_BAR_WORDS 3456
#define XB_SPIN_CAP (1u << 18)
__device__ __forceinline__ unsigned xb_ld(unsigned* p)              { return __hip_atomic_load(p, __ATOMIC_RELAXED, __HIP_MEMORY_SCOPE_AGENT); }
__device__ __forceinline__ unsigned xb_add(unsigned* p, unsigned v) { return __hip_atomic_fetch_add(p, v, __ATOMIC_RELAXED, __HIP_MEMORY_SCOPE_AGENT); }
__device__ __forceinline__ unsigned xb_xcc_id() { return (unsigned)__builtin_amdgcn_s_getreg((3 << 11) | 20) & 0xFu; }
#define XB_SPIN(cond, bar) do { unsigned _sp = 0; while (cond) { __builtin_amdgcn_s_sleep(1); \
    if ((++_sp & 255u) == 0u) { if (xb_ld(&(bar)[XB_TMO])) break; if (_sp > XB_SPIN_CAP) { atomicAdd(&(bar)[XB_TMO], 1u); break; } } } } while (0)
struct XcdBarrier { unsigned* bar; unsigned x; volatile LAS unsigned* st; };
__device__ __forceinline__ XcdBarrier xcd_barrier_post(unsigned* bar, volatile LAS unsigned* st) {
    XcdBarrier b; b.bar = bar; b.x = xb_xcc_id(); b.st = st;
    if (threadIdx.x == 0) (void)xb_add(&bar[XB_XCNT(b.x)], 1u);
    return b;
}
__device__ __forceinline__ void xcd_barrier_complete(unsigned* bar, unsigned x, unsigned& nloc, unsigned& nx) {
    const unsigned G = gridDim.x * gridDim.y * gridDim.z;
    unsigned sum, cnt, mine, sp = 0u;
    for (;;) {
        sum = 0u; cnt = 0u; mine = 0u;
#pragma unroll
        for (unsigned j = 0; j < 16; ++j) { const unsigned c = xb_ld(&bar[XB_XCNT(j)]); sum += c; cnt += (c > 0u) ? 1u : 0u; mine = (j == x) ? c : mine; }
        if (sum == G) break;
        __builtin_amdgcn_s_sleep(1);
        if ((++sp & 255u) == 0u) { if (xb_ld(&bar[XB_TMO])) break; if (sp > XB_SPIN_CAP) { atomicAdd(&bar[XB_TMO], 1u); break; } }
    }
    nloc = mine > 0u ? mine : 1u; nx = cnt > 0u ? cnt : 1u;
}
__device__ __forceinline__ void xcd_barrier(const XcdBarrier& b) {
    asm volatile("s_waitcnt vmcnt(0)" ::: "memory");
    __syncthreads();
    if (threadIdx.x == 0) {
        unsigned* bar = b.bar;
        __builtin_amdgcn_s_waitcnt(0);
        unsigned nloc = b.st[0], nx = b.st[1];
        if (nloc == 0u) { xcd_barrier_complete(bar, b.x, nloc, nx); b.st[0] = nloc; b.st[1] = nx; }
        const unsigned old = xb_add(&bar[XB_XSUB(b.x)], 1u);
        const unsigned gen = old / nloc;
        if (old + 1u == (gen + 1u) * nloc) {
            __builtin_amdgcn_fence(__ATOMIC_RELEASE, "agent");
            asm volatile("s_waitcnt vmcnt(0)" ::: "memory");
            const unsigned og = xb_add(&bar[XB_TOP], 1u);
            const unsigned tg = og / nx;
            if (og + 1u == (tg + 1u) * nx) xb_add(&bar[XB_TOPGEN], 1u);
            else XB_SPIN(xb_ld(&bar[XB_TOPGEN]) == tg, bar);
            __builtin_amdgcn_fence(__ATOMIC_ACQUIRE, "agent");
            xb_add(&bar[XB_XGEN(b.x)], 1u);
            asm volatile("s_waitcnt vmcnt(0)" ::: "memory");
        } else {
            XB_SPIN(xb_ld(&bar[XB_XGEN(b.x)]) == gen, bar);
            __builtin_amdgcn_fence(__ATOMIC_ACQUIRE, "agent");
            asm volatile("s_waitcnt vmcnt(0)" ::: "memory");
        }
    }
    __syncthreads();
}

struct Args { const void* in[28]; float* out; unsigned char* ws; int ph_lo, ph_hi; };
enum { I_X = 0, I_POS, I_NMG, I_WIN, I_BIN, I_ARE, I_AIM, I_LDT, I_BRE, I_BIM, I_CRE, I_CIM, I_SD, I_WGLU, I_BGLU, I_WBRS, I_SINK, I_WBRA, I_WO, I_NFG, I_WRG, I_BRG, I_WRE, I_BRE2, I_WEG, I_WEU, I_WED, I_NFIN };

struct SchedP1 {
    const char* XN; const char* WT; int G, c;
    __device__ __forceinline__ bool next(int i, pg8::Unit& u) const {
        const int L = i * G + c; if (L >= 32 * 26) return false;
        int pm, pn; pg8::grid_order(L, 32, 26, pm, pn);
        const size_t tstep = (size_t)256 * D * 2;
        if (pn == 9) { u.pm = 0; u.pn = pm; u.aux = 3; u.a = WT + 9 * tstep; u.b = XN + (size_t)pm * tstep; }
        else { u.pm = pm; u.pn = pn; u.aux = pn < 4 ? 0 : (pn < 8 ? 1 : (pn == 8 ? 2 : 4)); u.a = XN + (size_t)pm * tstep; u.b = WT + (size_t)pn * tstep; }
        u.aux2 = 0; return true;
    }
};
__constant__ double c_rope_rev[8] = {0.15915494309189535, 0.03086376340470123, 0.005985185712713705, 0.001160663641240061,
                                     0.00022507907903927653, 4.364795279280289e-05, 8.464330808241401e-06, 1.6414262627950345e-06};
struct EpiP1 {
    static constexpr bool KEEP = false; static constexpr bool PERM = true;
    bf16 *U, *Q, *Kb, *VT, *GATES; const float* bias; const int* pos;
    __device__ __forceinline__ void operator()(f32x4 (&acc)[2][2][4][2], const pg8::Unit& u, int wr, int wc, int fr, int fq) const {
        const int type = u.aux;
        const int row0 = u.pm * 256 + wr * 64 + fr, lc0 = wc * 32 + 8 * fq;
        if (type == 3) {
#pragma unroll
            for (int ai = 0; ai < 2; ++ai)
#pragma unroll
                for (int m = 0; m < 4; ++m) { const int r = row0 + ai * 128 + m * 16; const float bv = bias[2304 + r]; bf16* rowp = VT + (size_t)r * T + u.pn * 256 + lc0;
#pragma unroll
                    for (int bj = 0; bj < 2; ++bj) { const f32x4 v0 = acc[ai][bj][m][0] + bv, v1 = acc[ai][bj][m][1] + bv;
                        u32x4 w; w.x = pk2(v0[0], v0[1]); w.y = pk2(v0[2], v0[3]); w.z = pk2(v1[0], v1[1]); w.w = pk2(v1[2], v1[3]);
                        *(u32x4*)(rowp + bj * 128) = w; } }
            return;
        }
        const int gc0 = u.pn * 256 + lc0;
        f32x4 bv[2][2];
#pragma unroll
        for (int bj = 0; bj < 2; ++bj)
#pragma unroll
            for (int n = 0; n < 2; ++n) bv[bj][n] = *(const f32x4*)(bias + gc0 + bj * 128 + 4 * n);
        bf16* base; int ldc, colb; float sc = 1.f;
        if (type == 0) { base = U; ldc = 1024; colb = gc0; }
        else if (type == 1) { base = Q; ldc = 1024; colb = gc0 - 1024; sc = 0.125f; }
        else if (type == 2) { base = Kb; ldc = 256; colb = gc0 - 2048; }
        else { base = GATES; ldc = 4096; colb = gc0 - 2560; }
        const bool rope = (type == 1 || type == 2) && ((wc & 1) == 0);
        int posv[2][4];
        if (rope) {
#pragma unroll
            for (int ai = 0; ai < 2; ++ai)
#pragma unroll
                for (int m = 0; m < 4; ++m) posv[ai][m] = pos[row0 + ai * 128 + m * 16];
        }
        asm volatile("" ::: "memory");
#pragma unroll
        for (int ai = 0; ai < 2; ++ai)
#pragma unroll
            for (int m = 0; m < 4; ++m) {
                const int r = row0 + ai * 128 + m * 16;
                f32x4 v[2][2];
#pragma unroll
                for (int bj = 0; bj < 2; ++bj)
#pragma unroll
                    for (int n = 0; n < 2; ++n) v[bj][n] = acc[ai][bj][m][n] + bv[bj][n];
                if (rope) {
                    const double p = (double)posv[ai][m];
#pragma unroll
                    for (int n = 0; n < 2; ++n) {
                        f32x4 cs, sn;
#pragma unroll
                        for (int i = 0; i < 4; ++i) { const double rev = p * c_rope_rev[4 * n + i]; const float fr_ = (float)(rev - __builtin_rint(rev));
                            cs[i] = __builtin_amdgcn_cosf(fr_); sn[i] = __builtin_amdgcn_sinf(fr_); }
#pragma unroll
                        for (int bj = 0; bj < 2; ++bj) { const f32x4 x = v[bj][n]; f32x4 o;
#pragma unroll
                            for (int i = 0; i < 4; ++i) { const float pv = __shfl_xor(x[i], 16); o[i] = fq == 0 ? x[i] * cs[i] - pv * sn[i] : (fq == 1 ? x[i] * cs[i] + pv * sn[i] : x[i]); }
                            v[bj][n] = o; }
                    }
                }
                bf16* rowp = base + (size_t)r * ldc + colb;
#pragma unroll
                for (int bj = 0; bj < 2; ++bj) { f32x4 v0 = v[bj][0], v1 = v[bj][1];
                    if (type == 4) {
#pragma unroll
                        for (int i = 0; i < 4; ++i) { v0[i] = sigmoidf_(v0[i]); v1[i] = sigmoidf_(v1[i]); } }
                    else { v0 = v0 * sc; v1 = v1 * sc; }
                    u32x4 w; w.x = pk2(v0[0], v0[1]); w.y = pk2(v0[2], v0[3]); w.z = pk2(v1[0], v1[1]); w.w = pk2(v1[2], v1[3]);
                    *(u32x4*)(rowp + bj * 128) = w; }
                asm volatile("" ::: "memory");
            }
    }
};

struct SchedGrid {
    const char* A0; const char* B0; const char* A1; const char* B1; int nM, nN, rounds, K, G, c;
    __device__ __forceinline__ bool next(int i, pg8::Unit& u) const {
        const int L = i * G + c, nwg = nM * nN; if (L >= nwg * rounds) return false;
        const int rd = L / nwg; int pm, pn; pg8::grid_order(L - rd * nwg, nM, nN, pm, pn);
        const size_t tstep = (size_t)256 * K * 2;
        u.pm = pm; u.pn = pn; u.aux = rd; u.aux2 = 0; u.a = (rd ? A1 : A0) + (size_t)pm * tstep; u.b = (rd ? B1 : B0) + (size_t)pn * tstep; return true;
    }
};
struct EpiGlu {
    static constexpr bool KEEP = false; static constexpr bool PERM = true;
    bf16* Gout; const float* bias;
    __device__ __forceinline__ void operator()(f32x4 (&acc)[2][2][4][2], const pg8::Unit& u, int wr, int wc, int fr, int fq) const {
        const int row0 = u.pm * 256 + wr * 64 + fr, j0 = u.pn * 128 + wc * 32 + 8 * fq;
        f32x4 ba[2], bb[2];
#pragma unroll
        for (int n = 0; n < 2; ++n) { ba[n] = *(const f32x4*)(bias + j0 + 4 * n); bb[n] = *(const f32x4*)(bias + 1024 + j0 + 4 * n); }
#pragma unroll
        for (int ai = 0; ai < 2; ++ai)
#pragma unroll
            for (int m = 0; m < 4; ++m) { f32x4 o[2];
#pragma unroll
                for (int n = 0; n < 2; ++n) { const f32x4 a = acc[ai][0][m][n] + ba[n], b = acc[ai][1][m][n] + bb[n];
#pragma unroll
                    for (int i = 0; i < 4; ++i) o[n][i] = a[i] * sigmoidf_(b[i]); }
                u32x4 w; w.x = pk2(o[0][0], o[0][1]); w.y = pk2(o[0][2], o[0][3]); w.z = pk2(o[1][0], o[1][1]); w.w = pk2(o[1][2], o[1][3]);
                *(u32x4*)(Gout + (size_t)(row0 + ai * 128 + m * 16) * 1024 + j0) = w; }
    }
};
struct EpiMix {
    static constexpr bool KEEP = true; static constexpr bool PERM = true;
    bf16* MIX; const bf16* GATES;
    __device__ __forceinline__ void operator()(f32x4 (&acc)[2][2][4][2], const pg8::Unit& u, int wr, int wc, int fr, int fq) const {
        const int row0 = u.pm * 256 + wr * 64 + fr, c0 = u.pn * 256 + wc * 32 + 8 * fq, rd = u.aux;
#pragma unroll
        for (int ai = 0; ai < 2; ++ai) {
            u32x4 g0[4][2], g1[4][2];
#pragma unroll
            for (int m = 0; m < 4; ++m) { const size_t r = (size_t)(row0 + ai * 128 + m * 16);
#pragma unroll
                for (int bj = 0; bj < 2; ++bj) { g1[m][bj] = *(const u32x4*)(GATES + r * 4096 + 2048 + c0 + bj * 128);
                    g0[m][bj] = rd ? (u32x4){0u, 0u, 0u, 0u} : *(const u32x4*)(GATES + r * 4096 + c0 + bj * 128); } }
            asm volatile("" ::: "memory");
#pragma unroll
            for (int m = 0; m < 4; ++m) { const size_t r = (size_t)(row0 + ai * 128 + m * 16);
#pragma unroll
                for (int bj = 0; bj < 2; ++bj) { const u32x4 a = g0[m][bj], b = g1[m][bj];
                    if (rd == 0) {
                        f32x4 r0, r1;
                        r0[0] = bf_lo(a.x) * __builtin_amdgcn_rcpf(fmaxf(bf_lo(b.x), 1e-30f)); r0[1] = bf_hi(a.x) * __builtin_amdgcn_rcpf(fmaxf(bf_hi(b.x), 1e-30f));
                        r0[2] = bf_lo(a.y) * __builtin_amdgcn_rcpf(fmaxf(bf_lo(b.y), 1e-30f)); r0[3] = bf_hi(a.y) * __builtin_amdgcn_rcpf(fmaxf(bf_hi(b.y), 1e-30f));
                        r1[0] = bf_lo(a.z) * __builtin_amdgcn_rcpf(fmaxf(bf_lo(b.z), 1e-30f)); r1[1] = bf_hi(a.z) * __builtin_amdgcn_rcpf(fmaxf(bf_hi(b.z), 1e-30f));
                        r1[2] = bf_lo(a.w) * __builtin_amdgcn_rcpf(fmaxf(bf_lo(b.w), 1e-30f)); r1[3] = bf_hi(a.w) * __builtin_amdgcn_rcpf(fmaxf(bf_hi(b.w), 1e-30f));
                        acc[ai][bj][m][0] = acc[ai][bj][m][0] * r0; acc[ai][bj][m][1] = acc[ai][bj][m][1] * r1;
                    } else {
                        const f32x4 a0 = acc[ai][bj][m][0], a1 = acc[ai][bj][m][1];
                        u32x4 w; w.x = pk2(a0[0] * bf_lo(b.x), a0[1] * bf_hi(b.x)); w.y = pk2(a0[2] * bf_lo(b.y), a0[3] * bf_hi(b.y));
                        w.z = pk2(a1[0] * bf_lo(b.z), a1[1] * bf_hi(b.z)); w.w = pk2(a1[2] * bf_lo(b.w), a1[3] * bf_hi(b.w));
                        *(u32x4*)(MIX + r * 2048 + c0 + bj * 128) = w; } } }
            asm volatile("" ::: "memory");
        }
    }
};
struct EpiRes {
    static constexpr bool KEEP = false; static constexpr bool PERM = false;
    const float* X; float* H1;
    __device__ __forceinline__ void operator()(f32x4 (&acc)[2][2][4][2], const pg8::Unit& u, int wr, int wc, int fr, int fq) const {
        const int row0 = u.pm * 256 + wr * 64 + fr, c0 = u.pn * 256 + wc * 32 + 4 * fq;
#pragma unroll
        for (int ai = 0; ai < 2; ++ai)
#pragma unroll
            for (int mp = 0; mp < 2; ++mp) {
                f32x4 xv[2][2][2];
#pragma unroll
                for (int mm = 0; mm < 2; ++mm) { const size_t off = (size_t)(row0 + ai * 128 + (2 * mp + mm) * 16) * D + c0;
#pragma unroll
                    for (int bj = 0; bj < 2; ++bj)
#pragma unroll
                        for (int n = 0; n < 2; ++n) xv[mm][bj][n] = *(const f32x4*)(X + off + bj * 128 + n * 16); }
                asm volatile("" ::: "memory");
#pragma unroll
                for (int mm = 0; mm < 2; ++mm) { const size_t off = (size_t)(row0 + ai * 128 + (2 * mp + mm) * 16) * D + c0;
#pragma unroll
                    for (int bj = 0; bj < 2; ++bj)
#pragma unroll
                        for (int n = 0; n < 2; ++n) *(f32x4*)(H1 + off + bj * 128 + n * 16) = xv[mm][bj][n] + acc[ai][bj][2 * mp + mm][n]; }
                asm volatile("" ::: "memory");
            }
    }
};
namespace moe {
constexpr int BM = 320, BN = 128, BK = 32;
constexpr int APAIR = BM * 128, B_BYTES = BK * BN * 4, B_OFF = 2 * APAIR;
static_assert(B_OFF + 4 * B_BYTES <= MISC_OFF, "MoE buffers fit LDS");
struct Unit { int MT, nt, e, mtl; };
template <bool UP>
__device__ __forceinline__ void gemm(LAS unsigned char* lds, const Args& A, const volatile LAS int* pref, int G, int c) {
    constexpr int K = UP ? D : DE, NT = UP ? 8 : 16, nkt = K / BK, LDB = UP ? DE : D, APSTR = UP ? 128 : BM * 128;
    const int tid = threadIdx.x, wid = __builtin_amdgcn_readfirstlane(tid >> 6), lane = tid & 63;
    unsigned char* ws = A.ws;
    const int* cnt = (const int*)((const unsigned*)(ws + WS_CTL) + CW_CNT); const int* lista = (const int*)(ws + WS_LISTA); const float* listw = (const float*)(ws + WS_LISTW);
    const int tot = pref[64] * NT;
    auto next = [&](int i, Unit& u) -> bool {
        int L = i * G + c; if (L >= tot) return false;
        L = pg8::xcd_remap(L, tot);
        const int MT = L / NT; int lo = 0, hi = 64; while (hi - lo > 1) { const int mid = (lo + hi) >> 1; if (pref[mid] <= MT) lo = mid; else hi = mid; }
        u.MT = MT; u.nt = L - MT * NT; u.e = lo; u.mtl = MT - pref[lo]; return true; };
    Unit cur, nxt; int ui = 0;
    if (!next(0, cur)) return;
    if (wid >= 5) {
        const int lw = wid - 5;
        auto setup = [&](const Unit& u, const char* (&sa)[14], int (&ro)[14], const char* (&sb)[6]) {
            const int n = cnt[u.e];
#pragma unroll
            for (int j = 0; j < 14; ++j) { int a = lw + 3 * j; if (a > 39) a = 39; const int row = 8 * a + (lane >> 3), slot = u.mtl * BM + row, lc = (lane & 7) ^ (row & 7);
                if (UP) { const int sl = slot < n ? slot : n - 1; const int tok = lista[u.e * LIST_CAP + (sl > 0 ? sl : 0)] >> 1;
                    sa[j] = (const char*)(ws + WS_HN) + (size_t)tok * (D * 2) + lc * 16; ro[j] = tok & 31; }
                else ro[j] = 0, sa[j] = (const char*)(ws + WS_HB) + ((size_t)u.MT * (DE / 64) * BM + row) * 128 + lc * 16; }
#pragma unroll
            for (int j = 0; j < 6; ++j) { int b = lw + 3 * j; if (b > 15) b = 15; const int krow = 2 * b + (lane >> 5), lc = (lane & 31) ^ (((krow >> 3) & 1) << 2);
                if (UP) { const int grp = lc >> 2; const float* W = (const float*)A.in[(grp & 1) ? I_WEU : I_WEG] + (size_t)u.e * D * DE;
                    sb[j] = (const char*)(W + (size_t)krow * DE + 64 * u.nt + (grp >> 1) * 16 + (lc & 3) * 4); }
                else { const float* W = (const float*)A.in[I_WED] + (size_t)u.e * DE * D; sb[j] = (const char*)(W + (size_t)krow * D + 128 * u.nt + lc * 4); } }
        };
#define MOE_ISSUE_A(sa, ro, pr, pb) do { _Pragma("unroll") for (int j_ = 0; j_ < 14; ++j_) { const int a_ = lw + 3 * j_; if (a_ < 40) \
            __builtin_amdgcn_global_load_lds((const unsigned*)((sa)[j_] + (UP ? (size_t)((((pr) + (ro)[j_]) & 31) << 7) : (size_t)(pr) * APSTR)), (LAS unsigned*)(lds + (unsigned)(pb) * APAIR + (unsigned)a_ * 1024u), 16, 0, 0); } } while (0)
#define MOE_ISSUE_B(sb, kt, st) do { _Pragma("unroll") for (int j_ = 0; j_ < 6; ++j_) { const int b_ = lw + 3 * j_; if (b_ < 16) \
            __builtin_amdgcn_global_load_lds((const unsigned*)((sb)[j_] + (size_t)(kt) * ((size_t)BK * LDB * 4)), (LAS unsigned*)(lds + B_OFF + (unsigned)(st) * B_BYTES + (unsigned)b_ * 1024u), 16, 0, 2); } } while (0)
        const char* saC[14]; const char* saN[14]; const char* sbC[6]; const char* sbN[6]; int roC[14], roN[14];
        setup(cur, saC, roC, sbC);
        MOE_ISSUE_A(saC, roC, 0, 0); MOE_ISSUE_B(sbC, 0, 0); MOE_ISSUE_B(sbC, 1, 1); MOE_ISSUE_B(sbC, 2, 2);
        for (;;) {
            const bool has_next = next(ui + 1, nxt);
            if (has_next) setup(nxt, saN, roN, sbN);
            else {
#pragma unroll
                for (int j = 0; j < 14; ++j) saN[j] = saC[j], roN[j] = roC[j];
#pragma unroll
                for (int j = 0; j < 6; ++j) sbN[j] = sbC[j]; }
            for (int t0 = 0; t0 < nkt; t0 += 4) {
#pragma unroll
                for (int s = 0; s < 4; ++s) {
                    const int t = t0 + s;
                    if ((s & 1) == 0) { if (lw == 0) asm volatile("s_waitcnt vmcnt(12)" ::: "memory"); else asm volatile("s_waitcnt vmcnt(10)" ::: "memory"); }
                    else { if (lw == 0) asm volatile("s_waitcnt vmcnt(26)" ::: "memory"); else asm volatile("s_waitcnt vmcnt(23)" ::: "memory"); }
                    __builtin_amdgcn_s_barrier();
                    asm volatile("" ::: "memory");
                    if ((s & 1) == 0) {
                        const bool nxa = t + 2 >= nkt; const int pr = (nxa ? t + 2 - nkt : t + 2) >> 1;
                        const char* sa_[14]; int ro_[14];
#pragma unroll
                        for (int j = 0; j < 14; ++j) sa_[j] = nxa ? saN[j] : saC[j], ro_[j] = nxa ? roN[j] : roC[j];
                        MOE_ISSUE_A(sa_, ro_, pr, ((s >> 1) + 1) & 1);
                    }
                    { const bool nxb = t + 3 >= nkt; const int kt = nxb ? t + 3 - nkt : t + 3;
                      const char* sb_[6];
#pragma unroll
                      for (int j = 0; j < 6; ++j) sb_[j] = nxb ? sbN[j] : sbC[j];
                      MOE_ISSUE_B(sb_, kt, (s + 3) & 3); }
                }
            }
            if (!has_next) break;
            cur = nxt; ++ui;
#pragma unroll
            for (int j = 0; j < 14; ++j) saC[j] = saN[j], roC[j] = roN[j];
#pragma unroll
            for (int j = 0; j < 6; ++j) sbC[j] = sbN[j];
        }
        asm volatile("s_waitcnt vmcnt(0)" ::: "memory");
        __builtin_amdgcn_s_barrier();
#undef MOE_ISSUE_A
#undef MOE_ISSUE_B
    } else {
        const int fr = lane & 15, fq = lane >> 4;
        f32x4 acc[4][8];
#pragma unroll
        for (int rt = 0; rt < 4; ++rt)
#pragma unroll
            for (int ct = 0; ct < 8; ++ct) acc[rt][ct] = (f32x4){0.f, 0.f, 0.f, 0.f};
        const unsigned a_rd0 = (unsigned)((wid * 64 + fr) * 128 + ((fq ^ (fr & 7)) * 16));
        const unsigned a_rd1 = (unsigned)((wid * 64 + fr) * 128 + (((4 + fq) ^ (fr & 7)) * 16));
        const unsigned b_rdE = (unsigned)(B_OFF + 8 * fq * 512 + (fr + 16 * (fq & 1)) * 4);
        const unsigned b_rdO = (unsigned)(B_OFF + 8 * fq * 512 + (fr + 32 - 16 * (fq & 1)) * 4 - 128);
        for (;;) {
            const bool has_next = next(ui + 1, nxt);
            for (int t0 = 0; t0 < nkt; t0 += 4) {
#pragma unroll
                for (int s = 0; s < 4; ++s) {
                    __builtin_amdgcn_s_barrier();
                    asm volatile("" ::: "memory");
                    const unsigned sa = (unsigned)((s >> 1) & 1) * APAIR + ((s & 1) ? a_rd1 : a_rd0), sb = (unsigned)s * B_BYTES;
                    bf16x8 af[4];
#pragma unroll
                    for (int rt = 0; rt < 4; ++rt) af[rt] = *(const LAS bf16x8*)(lds + sa + rt * 2048);
#pragma unroll
                    for (int ch = 0; ch < 2; ++ch) {
                        bf16x8 bfv[4];
#pragma unroll
                        for (int c4 = 0; c4 < 4; ++c4) { const int ct = ch * 4 + c4; const LAS float* bq = (const LAS float*)(lds + sb + ((ct & 1) ? b_rdO : b_rdE) + 64 * ct);
                            u32x4 w; w.x = pk2(bq[0 * 128], bq[1 * 128]); w.y = pk2(bq[2 * 128], bq[3 * 128]); w.z = pk2(bq[4 * 128], bq[5 * 128]); w.w = pk2(bq[6 * 128], bq[7 * 128]);
                            bfv[c4] = __builtin_bit_cast(bf16x8, w); }
                        __builtin_amdgcn_s_setprio(1);
#pragma unroll
                        for (int rt = 0; rt < 4; ++rt)
#pragma unroll
                            for (int c4 = 0; c4 < 4; ++c4) acc[rt][ch * 4 + c4] = __builtin_amdgcn_mfma_f32_16x16x32_bf16(bfv[c4], af[rt], acc[rt][ch * 4 + c4], 0, 0, 0);
                        __builtin_amdgcn_s_setprio(0);
                    }
                    asm volatile("" ::: "memory");
                }
            }
            MFMA_SETTLE();
            if (UP) {
                bf16* HB = (bf16*)(ws + WS_HB);
#pragma unroll
                for (int rt = 0; rt < 4; ++rt) { bf16* rowp = HB + ((size_t)(cur.MT * NT + cur.nt) * BM + wid * 64 + rt * 16 + fr) * 64 + 4 * fq;
#pragma unroll
                    for (int cp = 0; cp < 4; ++cp) { const f32x4 g = acc[rt][2 * cp], uu = acc[rt][2 * cp + 1]; u32x2 w;
                        w.x = pk2(g[0] * sigmoidf_(g[0]) * uu[0], g[1] * sigmoidf_(g[1]) * uu[1]); w.y = pk2(g[2] * sigmoidf_(g[2]) * uu[2], g[3] * sigmoidf_(g[3]) * uu[3]);
                        *(u32x2*)(rowp + cp * 16) = w; } }
            } else {
                bf16* Y2 = (bf16*)(ws + WS_Y2); const int n = cnt[cur.e];
                int aid[4]; float wt[4];
#pragma unroll
                for (int rt = 0; rt < 4; ++rt) { const int slot = cur.mtl * BM + wid * 64 + rt * 16 + fr; const bool ok = slot < n; const int sl = ok ? slot : 0;
                    const int av = lista[cur.e * LIST_CAP + sl]; const float wv = listw[cur.e * LIST_CAP + sl]; aid[rt] = ok ? av : -1; wt[rt] = wv; }
                asm volatile("" ::: "memory");
#pragma unroll
                for (int rt = 0; rt < 4; ++rt) if (aid[rt] >= 0) { bf16* dst = Y2 + (size_t)aid[rt] * D + 128 * cur.nt + 4 * fq; const float w_ = wt[rt];
#pragma unroll
                    for (int ct = 0; ct < 8; ++ct) { const f32x4 v = acc[rt][ct] * w_; u32x2 w; w.x = pk2(v[0], v[1]); w.y = pk2(v[2], v[3]); *(u32x2*)(dst + ct * 16) = w; } }
            }
            if (!has_next) break;
#pragma unroll
            for (int rt = 0; rt < 4; ++rt)
#pragma unroll
                for (int ct = 0; ct < 8; ++ct) acc[rt][ct] = (f32x4){0.f, 0.f, 0.f, 0.f};
            cur = nxt; ++ui;
        }
        asm volatile("s_waitcnt vmcnt(0)" ::: "memory");
        __builtin_amdgcn_s_barrier();
    }
}
}

__device__ __forceinline__ void transpose_item(const float* W, int N, int K, bf16* WT, int k0, int n0, int drow0, LAS float* scr, int lane) {
#pragma unroll 8
    for (int i = 0; i < 32; ++i) { const int kk = 2 * i + (lane >> 5); scr[kk * 33 + (lane & 31)] = W[(size_t)(k0 + kk) * N + n0 + (lane & 31)]; }
    LDS_WAIT(); asm volatile("" ::: "memory");
    const int c = lane & 7;
#pragma unroll
    for (int j = 0; j < 4; ++j) { const int n = (lane >> 3) + 8 * j; const LAS float* s = scr + (8 * c) * 33 + n;
        u32x4 o; o.x = pk2(s[0 * 33], s[1 * 33]); o.y = pk2(s[2 * 33], s[3 * 33]); o.z = pk2(s[4 * 33], s[5 * 33]); o.w = pk2(s[6 * 33], s[7 * 33]);
        *(u32x4*)(WT + (size_t)(drow0 + n) * K + k0 + 8 * c) = o; }
    LDS_WAIT(); asm volatile("" ::: "memory");
}
__device__ __forceinline__ void sincos_d(double x, double& s, double& c) {
    const double n = __builtin_rint(x * 0.6366197723675814);
    double r = __builtin_fma(-n, 1.5707963267948966, x); r = __builtin_fma(-n, 6.123233995736766e-17, r);
    const double r2 = r * r;
    const double sp = r * (1.0 + r2 * (-1.0 / 6 + r2 * (1.0 / 120 + r2 * (-1.0 / 5040 + r2 * (1.0 / 362880 + r2 * (-1.0 / 39916800 + r2 * (1.0 / 6227020800.0 + r2 * (-1.0 / 1307674368000.0))))))));
    const double cp = 1.0 + r2 * (-0.5 + r2 * (1.0 / 24 + r2 * (-1.0 / 720 + r2 * (1.0 / 40320 + r2 * (-1.0 / 3628800 + r2 * (1.0 / 479001600 + r2 * (-1.0 / 87178291200.0)))))));
    const int q = ((int)n) & 3;
    s = (q == 0) ? sp : (q == 1) ? cp : (q == 2) ? -sp : -cp;
    c = (q == 0) ? cp : (q == 1) ? -sp : (q == 2) ? -cp : sp;
}
__device__ __forceinline__ double exp_d(double x) {
    const double k = __builtin_rint(x * 1.4426950408889634);
    double r = __builtin_fma(-k, 0.6931471805599453, x); r = __builtin_fma(-k, 2.3190468138462996e-17, r);
    double p = 1.0 / 479001600.0;
    p = p * r + 1.0 / 39916800.0; p = p * r + 1.0 / 3628800.0; p = p * r + 1.0 / 362880.0; p = p * r + 1.0 / 40320.0; p = p * r + 1.0 / 5040.0; p = p * r + 1.0 / 720.0;
    p = p * r + 1.0 / 120.0; p = p * r + 1.0 / 24.0; p = p * r + 1.0 / 6.0; p = p * r + 0.5; p = p * r + 1.0; p = p * r + 1.0;
    return __builtin_ldexp(p, (int)k);
}
constexpr int IT_WIN = 32 * 208, IT_GLU = 16 * 64, IT_BR = 16 * 64, IT_WO = 32 * 64, IT_EX = 64 * 512;
constexpr int IT_OTHERS = IT_GLU + 2 * IT_BR + IT_WO;
__device__ __forceinline__ void convert_later_weights(const Args& A, LAS unsigned char* lds, int gw, int NGW, int wave, int lane) {
    unsigned char* ws = A.ws;
    LAS float* scr = (LAS float*)(lds + wave * 16384);
    for (int it = gw; it < IT_OTHERS; it += NGW) {
        int r = it;
        if (r < IT_GLU) { const int kb = r / 64, nb = r % 64, n0 = 32 * nb, hf = n0 >> 10, j0 = n0 & 1023;
            transpose_item((const float*)A.in[I_WGLU], 2048, 1024, (bf16*)(ws + WS_WGLU), 64 * kb, n0, (j0 >> 7) * 256 + hf * 128 + (j0 & 127), scr, lane); continue; } r -= IT_GLU;
        if (r < IT_BR) { const int kb = r / 64, nb = r % 64; transpose_item((const float*)A.in[I_WBRS], 2048, 1024, (bf16*)(ws + WS_WBRS), 64 * kb, 32 * nb, 32 * nb, scr, lane); continue; } r -= IT_BR;
        if (r < IT_BR) { const int kb = r / 64, nb = r % 64; transpose_item((const float*)A.in[I_WBRA], 2048, 1024, (bf16*)(ws + WS_WBRA), 64 * kb, 32 * nb, 32 * nb, scr, lane); continue; } r -= IT_BR;
        { const int kb = r / 64, nb = r % 64; transpose_item((const float*)A.in[I_WO], 2048, 2048, (bf16*)(ws + WS_WO), 64 * kb, 32 * nb, 32 * nb, scr, lane); }
    }
}
__device__ __forceinline__ void p0_prologue(const Args& A, LAS unsigned char* lds, int gw, int NGW, int wave, int lane) {
    unsigned char* ws = A.ws;
    LAS float* scr = (LAS float*)(lds + wave * 16384);
    for (int it = gw; it < IT_WIN; it += NGW) { const int kb = it / 208, nb = it % 208; transpose_item((const float*)A.in[I_WIN], INW, D, (bf16*)(ws + WS_WIN), 64 * kb, 32 * nb, 32 * nb, scr, lane); }
    { const f32x4* gp = (const f32x4*)A.in[I_NMG] + lane; f32x4 gv[8];
#pragma unroll
      for (int j = 0; j < 8; ++j) gv[j] = gp[64 * j];
      for (int m = gw; m < T; m += 2 * NGW) {
        const int m2 = m + NGW < T ? m + NGW : m;
        const f32x4* xr = (const f32x4*)((const float*)A.in[I_X] + (size_t)m * D) + lane; const f32x4* xr2 = (const f32x4*)((const float*)A.in[I_X] + (size_t)m2 * D) + lane;
        f32x4 v[8], v2[8]; float s = 0.f, s2 = 0.f;
#pragma unroll
        for (int j = 0; j < 8; ++j) { v[j] = xr[64 * j]; v2[j] = xr2[64 * j]; }
#pragma unroll
        for (int j = 0; j < 8; ++j) { s += (v[j].x * v[j].x + v[j].y * v[j].y) + (v[j].z * v[j].z + v[j].w * v[j].w); s2 += (v2[j].x * v2[j].x + v2[j].y * v2[j].y) + (v2[j].z * v2[j].z + v2[j].w * v2[j].w); }
        const float rstd = 1.0f / sqrtf(wave_sum(s) * (1.0f / D) + EPS), rstd2 = 1.0f / sqrtf(wave_sum(s2) * (1.0f / D) + EPS);
        u32x2* o8 = (u32x2*)((bf16*)(ws + WS_XN) + (size_t)m * D) + lane; u32x2* o82 = (u32x2*)((bf16*)(ws + WS_XN) + (size_t)m2 * D) + lane;
#pragma unroll
        for (int j = 0; j < 8; ++j) { const f32x4 y = v[j] * rstd * gv[j]; u32x2 w; w.x = pk2(y.x, y.y); w.y = pk2(y.z, y.w); o8[64 * j] = w;
            const f32x4 y2 = v2[j] * rstd2 * gv[j]; u32x2 w2; w2.x = pk2(y2.x, y2.y); w2.y = pk2(y2.z, y2.w); o82[64 * j] = w2; }
      } }
}
__device__ __forceinline__ void p0_tables(const Args& A, int gw, int NGW, int lane) {
    unsigned char* ws = A.ws;
    for (int idx = gw * 64 + lane; idx < 80 * D; idx += NGW * 64) {
        const int k = idx / 80, r = idx - k * 80;
        const float v = r < 64 ? ((const float*)A.in[I_WRE])[(size_t)k * 64 + r] : (r < 72 ? ((const float*)A.in[I_WRG])[(size_t)k * 8 + (r - 64)] : 0.f);
        const unsigned hb = pk2(v, 0.f) & 0xffffu; const float hf = bf_lo(hb);
        bf16* wr = (bf16*)(ws + WS_WR);
        wr[(size_t)r * D + k] = (bf16)hb; wr[(size_t)(80 + r) * D + k] = (bf16)(pk2(v - hf, 0.f) & 0xffffu);
    }
    for (int idx = gw * 64 + lane; idx < SGRP * SST; idx += NGW * 64) {
        const int g = idx >> 6, p = idx & 63;
        const double lr = (double)fminf(((const float*)A.in[I_ARE])[idx], -1e-4f), li = (double)((const float*)A.in[I_AIM])[idx];
        const double dt = exp_d((double)((const float*)A.in[I_LDT])[g]);
        double s1, c1, sL, cL; sincos_d(li * dt, s1, c1); sincos_d(li * dt * LSEG, sL, cL);
        const double mag = exp_d(lr * dt), magL = exp_d(lr * dt * LSEG);
        const double are = mag * c1, aim = mag * s1;
        ((f32x2*)(ws + WS_TAB + TAB_ABAR))[idx] = (f32x2){(float)are, (float)aim};
        ((f32x2*)(ws + WS_TAB + TAB_ABARL))[idx] = (f32x2){(float)(magL * cL), (float)(magL * sL)};
        const double den = lr * lr + li * li, nr = are - 1.0, ni = aim;
        const double cre = (nr * lr + ni * li) / den, cim = (ni * lr - nr * li) / den;
        const float* br = (const float*)A.in[I_BRE] + (size_t)idx * SCH; const float* bi = (const float*)A.in[I_BIM] + (size_t)idx * SCH;
        bf16* bbr = (bf16*)(ws + WS_TAB + TAB_BB) + ((size_t)(g * 2 + 0) * 64 + p) * 16; bf16* bbi = (bf16*)(ws + WS_TAB + TAB_BB) + ((size_t)(g * 2 + 1) * 64 + p) * 16;
#pragma unroll
        for (int c = 0; c < 16; c += 2) {
            const double r0 = cre * br[c] - cim * bi[c], i0 = cre * bi[c] + cim * br[c], r1 = cre * br[c + 1] - cim * bi[c + 1], i1 = cre * bi[c + 1] + cim * br[c + 1];
            *(unsigned*)(bbr + c) = pk2((float)r0, (float)r1); *(unsigned*)(bbi + c) = pk2((float)i0, (float)i1); }
        const float* cr = (const float*)A.in[I_CRE] + (size_t)g * SCH * SST + p; const float* ci = (const float*)A.in[I_CIM] + (size_t)g * SCH * SST + p;
        bf16* cm = (bf16*)(ws + WS_TAB + TAB_CM) + (size_t)g * 16 * 128 + 2 * p;
#pragma unroll
        for (int c = 0; c < 16; ++c) *(unsigned*)(cm + c * 128) = pk2(cr[c * SST], -ci[c * SST]);
    }
}

__device__ __forceinline__ float gelu_tanh(float y) { const float w = 0.7978845608028654f * (y + 0.044715f * y * y * y); return y * __builtin_amdgcn_rcpf(1.0f + fast_exp(-2.0f * w)); }
template <bool PASS2>
__device__ __forceinline__ void ssm_task(const Args& A, int g, int s0, int s1, LAS unsigned char* xs, int lane) {
    unsigned char* ws = A.ws;
    const bf16* U = (const bf16*)(ws + WS_U);
    const int n = lane & 31, hi = lane >> 5, seg = hi ? s1 : s0;
    const int rb2 = (n >> 2) & 1, rstep = 4 * (n >> 3) + (n & 3);
    const bf16* up = U + (size_t)((rb2 ? s1 : s0) * LSEG + rstep) * SSMW + g * SCH + 8 * hi;
    bf16x8 bfr[2][2];
#pragma unroll
    for (int part = 0; part < 2; ++part)
#pragma unroll
        for (int q = 0; q < 2; ++q) bfr[part][q] = *(const bf16x8*)((const bf16*)(ws + WS_TAB + TAB_BB) + ((size_t)(g * 2 + part) * 64 + n + 32 * q) * 16 + 8 * hi);
    float ar[2], ai[2], xr[2] = {0.f, 0.f}, xi[2] = {0.f, 0.f};
#pragma unroll
    for (int q = 0; q < 2; ++q) { const f32x2 a = ((const f32x2*)(ws + WS_TAB + TAB_ABAR))[g * 64 + n + 32 * q]; ar[q] = a.x; ai[q] = a.y; }
    f32x2* Ebase = (f32x2*)(ws + WS_E) + (size_t)g * NSEG * 64;
    bf16x8 cmf[4];
    if constexpr (PASS2) {
        float lr[2], li[2];
#pragma unroll
        for (int q = 0; q < 2; ++q) { const f32x2 a = ((const f32x2*)(ws + WS_TAB + TAB_ABARL))[g * 64 + n + 32 * q]; lr[q] = a.x; li[q] = a.y; }
        for (int j0 = 0; j0 < s1; j0 += 16) {
            f32x2 e[16][2];
#pragma unroll
            for (int jj = 0; jj < 16; ++jj)
#pragma unroll
                for (int q = 0; q < 2; ++q) e[jj][q] = Ebase[(size_t)((j0 + jj) & 63) * 64 + n + 32 * q];
#pragma unroll
            for (int jj = 0; jj < 16; ++jj) if (j0 + jj < seg) {
#pragma unroll
                for (int q = 0; q < 2; ++q) { const float nr = lr[q] * xr[q] - li[q] * xi[q] + e[jj][q].x, ni = lr[q] * xi[q] + li[q] * xr[q] + e[jj][q].y; xr[q] = nr; xi[q] = ni; } }
        }
#pragma unroll
        for (int ks = 0; ks < 4; ++ks) cmf[ks] = *(const bf16x8*)((const bf16*)(ws + WS_TAB + TAB_CM) + ((size_t)g * 16 + (lane & 15)) * 128 + 32 * ks + 8 * (lane >> 4));
    }
    bf16x8 af_n = *(const bf16x8*)up;
    f32x4 dv = {0.f, 0.f, 0.f, 0.f};
    if constexpr (PASS2) dv = *(const f32x4*)((const float*)A.in[I_SD] + g * SCH + 4 * (lane >> 4));
    for (int blk = 0; blk < LSEG / 16; ++blk) {
        const bf16x8 af = af_n;
        if (blk + 1 < LSEG / 16) af_n = *(const bf16x8*)(up + (size_t)(blk + 1) * 16 * SSMW);
        u32x2 uvp[2];
        if constexpr (PASS2) {
#pragma unroll
            for (int hh = 0; hh < 2; ++hh) uvp[hh] = *(const u32x2*)(U + (size_t)((hh ? s1 : s0) * LSEG + blk * 16 + (lane & 15)) * SSMW + g * SCH + 4 * (lane >> 4)); }
        f32x16 br[2], bi[2];
        const f32x16 zero = {0.f, 0.f, 0.f, 0.f, 0.f, 0.f, 0.f, 0.f, 0.f, 0.f, 0.f, 0.f, 0.f, 0.f, 0.f, 0.f};
#pragma unroll
        for (int q = 0; q < 2; ++q) { br[q] = __builtin_amdgcn_mfma_f32_32x32x16_bf16(af, bfr[0][q], zero, 0, 0, 0); bi[q] = __builtin_amdgcn_mfma_f32_32x32x16_bf16(af, bfr[1][q], zero, 0, 0, 0); }
        MFMA_SETTLE();
#pragma unroll
        for (int i = 0; i < 16; ++i)
#pragma unroll
            for (int q = 0; q < 2; ++q) {
                const float nr = ar[q] * xr[q] - ai[q] * xi[q] + br[q][i], ni = ar[q] * xi[q] + ai[q] * xr[q] + bi[q][i]; xr[q] = nr; xi[q] = ni;
                if constexpr (PASS2) *(LAS unsigned*)(xs + ((hi * 16 + i) * 68 + n + 32 * q) * 4) = pk2(nr, ni);
            }
        if constexpr (PASS2) {
            LDS_WAIT(); __builtin_amdgcn_wave_barrier();
#pragma unroll
            for (int hh = 0; hh < 2; ++hh) {
                f32x4 y = {0.f, 0.f, 0.f, 0.f};
#pragma unroll
                for (int ks = 0; ks < 4; ++ks) { const bf16x8 xf = *(const LAS bf16x8*)(xs + (hh * 16 + (lane & 15)) * 272 + 64 * ks + 16 * (lane >> 4));
                    y = __builtin_amdgcn_mfma_f32_16x16x32_bf16(cmf[ks], xf, y, 0, 0, 0); }
                MFMA_SETTLE();
                const int t = (hh ? s1 : s0) * LSEG + blk * 16 + (lane & 15), ch = g * SCH + 4 * (lane >> 4);
                const u32x2 uv = uvp[hh];
                const float y0 = gelu_tanh(y[0] + dv[0] * bf_lo(uv.x)), y1 = gelu_tanh(y[1] + dv[1] * bf_hi(uv.x)), y2 = gelu_tanh(y[2] + dv[2] * bf_lo(uv.y)), y3 = gelu_tanh(y[3] + dv[3] * bf_hi(uv.y));
                u32x2 w; w.x = pk2(y0, y1); w.y = pk2(y2, y3);
                *(u32x2*)((bf16*)(ws + WS_Z) + (size_t)t * SSMW + ch) = w;
            }
            LDS_WAIT(); __builtin_amdgcn_wave_barrier();
        }
    }
    if constexpr (!PASS2) {
#pragma unroll
        for (int q = 0; q < 2; ++q) Ebase[(size_t)seg * 64 + n + 32 * q] = (f32x2){xr[q], xi[q]};
    }
}

constexpr int AT_KP = 144, AT_VP = 520, AT_VOFF = 256 * AT_KP;
__device__ __forceinline__ void attn_stage(const Args& A, LAS unsigned char* lds, int QB, int kvh, int tid) {
    unsigned char* ws = A.ws;
    const bf16* Kb = (const bf16*)(ws + WS_K); const bf16* VT = (const bf16*)(ws + WS_VT);
    const int kb0 = QB * 128 - 128;
    u32x4 kv[4], vv[4];
#pragma unroll
    for (int p = 0; p < 4; ++p) { const int row = (tid >> 3) + 64 * p, key = kb0 + row; kv[p] = key >= 0 ? *(const u32x4*)(Kb + (size_t)key * 256 + kvh * 64 + (tid & 7) * 8) : (u32x4){0u, 0u, 0u, 0u}; }
#pragma unroll
    for (int p = 0; p < 4; ++p) { const int d = (tid >> 5) + 16 * p, key = kb0 + (tid & 31) * 8; vv[p] = key >= 0 ? *(const u32x4*)(VT + (size_t)(kvh * 64 + d) * T + key) : (u32x4){0u, 0u, 0u, 0u}; }
#pragma unroll
    for (int p = 0; p < 4; ++p) *(LAS u32x4*)(lds + ((tid >> 3) + 64 * p) * AT_KP + (tid & 7) * 16) = kv[p];
#pragma unroll
    for (int p = 0; p < 4; ++p) { LAS unsigned char* dp = lds + AT_VOFF + ((tid >> 5) + 16 * p) * AT_VP + (tid & 31) * 16;
        *(LAS u32x2*)dp = (u32x2){vv[p].x, vv[p].y}; *(LAS u32x2*)(dp + 8) = (u32x2){vv[p].z, vv[p].w}; }
}
__device__ __forceinline__ void attn_task(const Args& A, const LAS unsigned char* lds, int QB, int a, int head, int lane) {
    unsigned char* ws = A.ws;
    const bf16* Q = (const bf16*)(ws + WS_Q); bf16* O = (bf16*)(ws + WS_O);
    const int q0 = QB * 128 + 32 * a, n = lane & 31, hi = lane >> 5;
    bf16x8 qf[4];
    { const bf16* qp = Q + (size_t)(q0 + n) * 1024 + head * 64 + 8 * hi;
#pragma unroll
      for (int ks = 0; ks < 4; ++ks) qf[ks] = *(const bf16x8*)(qp + 16 * ks); }
    f32x16 s[5];
    const float NEG = -1e30f;
#pragma unroll
    for (int kt = 0; kt < 5; ++kt) {
        const int kb = q0 - 128 + 32 * kt;
        f32x16 acc = {0.f, 0.f, 0.f, 0.f, 0.f, 0.f, 0.f, 0.f, 0.f, 0.f, 0.f, 0.f, 0.f, 0.f, 0.f, 0.f};
        if (kb >= 0) { const LAS unsigned char* kp = lds + (32 * (a + kt) + n) * AT_KP + 16 * hi;
#pragma unroll
            for (int ks = 0; ks < 4; ++ks) { const bf16x8 kf = *(const LAS bf16x8*)(kp + 32 * ks); acc = __builtin_amdgcn_mfma_f32_32x32x16_bf16(kf, qf[ks], acc, 0, 0, 0); } }
        MFMA_SETTLE();
#pragma unroll
        for (int i = 0; i < 16; ++i) { const int kl = (i & 3) + 8 * (i >> 2) + 4 * hi;
            bool ok = kb >= 0; if (kt == 0) ok = ok && (kl >= n + 1); if (kt == 4) ok = ok && (kl <= n);
            acc[i] = ok ? acc[i] : NEG; }
        s[kt] = acc;
    }
    float m = NEG;
#pragma unroll
    for (int kt = 0; kt < 5; ++kt)
#pragma unroll
        for (int i = 0; i < 16; ++i) m = fmaxf(m, s[kt][i]);
    m = fmaxf(m, __shfl_xor(m, 32));
    const float sink = ((const float*)A.in[I_SINK])[head];
    m = fmaxf(m, sink);
    float l = 0.f;
#pragma unroll
    for (int kt = 0; kt < 5; ++kt)
#pragma unroll
        for (int i = 0; i < 16; ++i) { const float p = fast_exp(s[kt][i] - m); s[kt][i] = p; l += p; }
    l += __shfl_xor(l, 32);
    const float inv = 1.0f / (l + fast_exp(sink - m));
    f32x16 o[2];
#pragma unroll
    for (int dt = 0; dt < 2; ++dt) o[dt] = (f32x16){0.f, 0.f, 0.f, 0.f, 0.f, 0.f, 0.f, 0.f, 0.f, 0.f, 0.f, 0.f, 0.f, 0.f, 0.f, 0.f};
#pragma unroll
    for (int kt = 0; kt < 5; ++kt) {
        const int kb = q0 - 128 + 32 * kt;
        if (kb >= 0) {
#pragma unroll
            for (int s2 = 0; s2 < 2; ++s2) {
                u32x4 pp; pp.x = pk2(s[kt][8 * s2 + 0] * inv, s[kt][8 * s2 + 1] * inv); pp.y = pk2(s[kt][8 * s2 + 2] * inv, s[kt][8 * s2 + 3] * inv);
                pp.z = pk2(s[kt][8 * s2 + 4] * inv, s[kt][8 * s2 + 5] * inv); pp.w = pk2(s[kt][8 * s2 + 6] * inv, s[kt][8 * s2 + 7] * inv);
                const bf16x8 pf = __builtin_bit_cast(bf16x8, pp);
#pragma unroll
                for (int dt = 0; dt < 2; ++dt) { const LAS unsigned char* vp = lds + AT_VOFF + (dt * 32 + n) * AT_VP + (32 * (a + kt) + 16 * s2 + 4 * hi) * 2;
                    const u32x2 lo = *(const LAS u32x2*)vp, hi8 = *(const LAS u32x2*)(vp + 16);
                    const bf16x8 vf = __builtin_bit_cast(bf16x8, (u32x4){lo.x, lo.y, hi8.x, hi8.y});
                    o[dt] = __builtin_amdgcn_mfma_f32_32x32x16_bf16(pf, vf, o[dt], 0, 0, 0); }
            }
        }
    }
    MFMA_SETTLE();
#pragma unroll
    for (int dt = 0; dt < 2; ++dt)
#pragma unroll
        for (int i = 0; i < 16; ++i) { const int qr = (i & 3) + 8 * (i >> 2) + 4 * hi;
            O[(size_t)(q0 + qr) * 1024 + head * 64 + dt * 32 + n] = (bf16)(pk2(o[dt][i], 0.f) & 0xffffu); }
}

__device__ __forceinline__ void router_block(const Args& A, LAS unsigned char* lds, int tok0, int tid, int wave, int lane) {
    unsigned char* ws = A.ws;
    LAS float* RSTD = (LAS float*)lds; LAS float* PART = (LAS float*)(lds + 1024); LAS float* LOG = (LAS float*)(lds + 1024 + 81920);
    const float* H1 = (const float*)(ws + WS_H1);
#pragma unroll 1
    for (int tt = 0; tt < 4; ++tt) {
        const int tl = 4 * wave + tt;
        const f32x4* hr = (const f32x4*)(H1 + (size_t)(tok0 + tl) * D) + lane; float s = 0.f;
#pragma unroll
        for (int j = 0; j < 8; ++j) { const f32x4 v = hr[64 * j]; s += (v.x * v.x + v.y * v.y) + (v.z * v.z + v.w * v.w); }
        s = wave_sum(s);
        if (lane == 0) RSTD[tl] = 1.0f / sqrtf(s * (1.0f / D) + EPS);
    }
    __syncthreads();
    {
        const int fr = lane & 15, fq = lane >> 4;
        const bf16* WR = (const bf16*)(ws + WS_WR);
        f32x4 acc[5][2];
#pragma unroll
        for (int et = 0; et < 5; ++et)
#pragma unroll
            for (int tt = 0; tt < 2; ++tt) acc[et][tt] = (f32x4){0.f, 0.f, 0.f, 0.f};
        const float rs0 = RSTD[fr], rs1 = RSTD[16 + fr];
#pragma unroll 2
        for (int ks = 0; ks < 8; ++ks) {
            const int k = 256 * wave + 32 * ks + 8 * fq;
            const f32x4 g0 = *(const f32x4*)((const float*)A.in[I_NFG] + k), g1 = *(const f32x4*)((const float*)A.in[I_NFG] + k + 4);
            bf16x8 hh[2], hl[2];
#pragma unroll
            for (int tt = 0; tt < 2; ++tt) {
                const float* hp = H1 + (size_t)(tok0 + tt * 16 + fr) * D + k; const float rs = tt ? rs1 : rs0;
                const f32x4 a = *(const f32x4*)hp * rs * g0, b = *(const f32x4*)(hp + 4) * rs * g1;
                u32x4 hi; hi.x = pk2(a.x, a.y); hi.y = pk2(a.z, a.w); hi.z = pk2(b.x, b.y); hi.w = pk2(b.z, b.w);
                u32x4 lo; lo.x = pk2(a.x - bf_lo(hi.x), a.y - bf_hi(hi.x)); lo.y = pk2(a.z - bf_lo(hi.y), a.w - bf_hi(hi.y)); lo.z = pk2(b.x - bf_lo(hi.z), b.y - bf_hi(hi.z)); lo.w = pk2(b.z - bf_lo(hi.w), b.w - bf_hi(hi.w));
                { const int tokr = tok0 + tt * 16 + fr;
                  *(u32x4*)((bf16*)(ws + WS_HN) + (size_t)tokr * D + ((((k >> 6) + tokr) & 31) << 6) + (k & 63)) = hi; }
                hh[tt] = __builtin_bit_cast(bf16x8, hi); hl[tt] = __builtin_bit_cast(bf16x8, lo);
            }
#pragma unroll
            for (int et = 0; et < 5; ++et) {
                const bf16x8 wh = *(const bf16x8*)(WR + (size_t)(et * 16 + fr) * D + k), wl = *(const bf16x8*)(WR + (size_t)(80 + et * 16 + fr) * D + k);
#pragma unroll
                for (int tt = 0; tt < 2; ++tt) {
                    acc[et][tt] = __builtin_amdgcn_mfma_f32_16x16x32_bf16(wh, hh[tt], acc[et][tt], 0, 0, 0);
                    acc[et][tt] = __builtin_amdgcn_mfma_f32_16x16x32_bf16(wh, hl[tt], acc[et][tt], 0, 0, 0);
                    acc[et][tt] = __builtin_amdgcn_mfma_f32_16x16x32_bf16(wl, hh[tt], acc[et][tt], 0, 0, 0);
                }
            }
        }
        MFMA_SETTLE();
#pragma unroll
        for (int et = 0; et < 5; ++et)
#pragma unroll
            for (int tt = 0; tt < 2; ++tt)
#pragma unroll
                for (int i = 0; i < 4; ++i) PART[(wave * 80 + et * 16 + 4 * fq + i) * 32 + tt * 16 + fr] = acc[et][tt][i];
    }
    __syncthreads();
    for (int i = tid; i < 72 * 32; i += NWAVES * 64) { const int o = i >> 5, t = i & 31;
        const float b = o < 64 ? ((const float*)A.in[I_BRE2])[o] : ((const float*)A.in[I_BRG])[o - 64];
        float s = 0.f;
#pragma unroll
        for (int w = 0; w < 8; ++w) s += PART[(w * 80 + o) * 32 + t];
        LOG[t * 72 + o] = s + b; }
    __syncthreads();
    if (tid < 32) {
        const int t = tok0 + tid; const LAS float* lg = LOG + tid * 72;
        float gb = lg[64]; int gi = 0;
#pragma unroll
        for (int j = 1; j < 8; ++j) { const float v = lg[64 + j]; if (v > gb) { gb = v; gi = j; } }
        float se = 0.f;
#pragma unroll
        for (int j = 0; j < 8; ++j) se += expf(lg[64 + j] - gb);
        const float pgrp = 1.0f / se;
        const LAS float* le = lg + gi * 8;
        float b0 = le[0]; int i0 = 0;
#pragma unroll
        for (int j = 1; j < 8; ++j) { const float v = le[j]; if (v > b0) { b0 = v; i0 = j; } }
        float b1 = -3.0e38f; int i1 = 0;
#pragma unroll
        for (int j = 0; j < 8; ++j) { const float v = le[j]; if (j != i0 && v > b1) { b1 = v; i1 = j; } }
        const float ex = expf(b1 - b0), w0 = 1.0f / (1.0f + ex), w1 = ex * w0;
        unsigned* cnt = (unsigned*)(ws + WS_CTL) + CW_CNT;
        const int e0 = gi * 8 + i0, e1 = gi * 8 + i1;
        const unsigned sl0 = __hip_atomic_fetch_add(cnt + e0, 1u, __ATOMIC_RELAXED, __HIP_MEMORY_SCOPE_AGENT);
        const unsigned sl1 = __hip_atomic_fetch_add(cnt + e1, 1u, __ATOMIC_RELAXED, __HIP_MEMORY_SCOPE_AGENT);
        ((int*)(ws + WS_LISTA))[e0 * LIST_CAP + sl0] = 2 * t;     ((float*)(ws + WS_LISTW))[e0 * LIST_CAP + sl0] = w0 * pgrp;
        ((int*)(ws + WS_LISTA))[e1 * LIST_CAP + sl1] = 2 * t + 1; ((float*)(ws + WS_LISTW))[e1 * LIST_CAP + sl1] = w1 * pgrp;
    }
    __syncthreads();
}

__device__ __forceinline__ void final_rows(const Args& A, int gw, int NGW, int lane) {
    unsigned char* ws = A.ws;
    const f32x4* gp = (const f32x4*)A.in[I_NFIN] + lane;
    for (int m = gw; m < T; m += NGW) {
        const f32x4* hr = (const f32x4*)((const float*)(ws + WS_H1) + (size_t)m * D) + lane;
        const u32x2* y0 = (const u32x2*)((const bf16*)(ws + WS_Y2) + (size_t)(2 * m) * D) + lane; const u32x2* y1 = (const u32x2*)((const bf16*)(ws + WS_Y2) + (size_t)(2 * m + 1) * D) + lane;
        f32x4 v[8]; float s = 0.f;
#pragma unroll
        for (int j = 0; j < 8; ++j) { const u32x2 a = y0[64 * j], b = y1[64 * j]; f32x4 h = hr[64 * j];
            h.x += bf_lo(a.x) + bf_lo(b.x); h.y += bf_hi(a.x) + bf_hi(b.x); h.z += bf_lo(a.y) + bf_lo(b.y); h.w += bf_hi(a.y) + bf_hi(b.y);
            v[j] = h; s += (h.x * h.x + h.y * h.y) + (h.z * h.z + h.w * h.w); }
        const float rstd = 1.0f / sqrtf(wave_sum(s) * (1.0f / D) + EPS);
        f32x4* o = (f32x4*)(A.out + (size_t)m * D) + lane;
#pragma unroll
        for (int j = 0; j < 8; ++j) o[64 * j] = v[j] * rstd * gp[64 * j];
    }
}

__global__ void __launch_bounds__(NWAVES * 64, 2) mega_fwd(Args args) {
    extern __shared__ __attribute__((aligned(16))) unsigned char lds_raw[];
    LAS unsigned char* lds = (LAS unsigned char*)lds_raw;
    volatile LAS unsigned* MISC = (volatile LAS unsigned*)(lds + MISC_OFF);
    const int tid = threadIdx.x, lane = tid & 63, wave = __builtin_amdgcn_readfirstlane(tid >> 6);
    const int G = gridDim.x, bx = blockIdx.x;
    const int vcu = (G % 8 == 0) ? (bx % 8) * (G / 8) + bx / 8 : bx;
    const int gw = vcu * NWAVES + wave, NGW = G * NWAVES;
    unsigned char* ws = args.ws;
    unsigned* ctl = (unsigned*)(ws + WS_CTL);
    for (int u = tid; u < 256; u += NWAVES * 64) MISC[u] = 0u;
    __syncthreads();
    XcdBarrier bar; bar.bar = ctl + CW_BAR; bar.x = 0; bar.st = nullptr;
    if (N_LAUNCHES == 1) bar = xcd_barrier_post(ctl + CW_BAR, MISC + 8);
    const int lo = args.ph_lo, hi = args.ph_hi;
#define IN(k) (((PHMASK >> (k)) & 1) && lo <= (k) && (k) < hi)
#define SEAM(k) do { if (IN(k) && IN((k) + 1)) xcd_barrier(bar); } while (0)

    if (IN(0)) REP(0) { p0_prologue(args, lds, gw, NGW, wave, lane); }
    SEAM(0);
    if (IN(1)) REP(1) {
        SchedP1 S{(const char*)(ws + WS_XN), (const char*)(ws + WS_WIN), G, bx};
        EpiP1 E{(bf16*)(ws + WS_U), (bf16*)(ws + WS_Q), (bf16*)(ws + WS_K), (bf16*)(ws + WS_VT), (bf16*)(ws + WS_GATES), (const float*)args.in[I_BIN], (const int*)args.in[I_POS]};
        pg8::gemm_phase<EpiP1, SchedP1, true, true, false>(lds, D, S, E);
        if (G == 256 ? bx >= 64 : true) { const int nb_ = G == 256 ? 192 : G, ib_ = G == 256 ? bx - 64 : bx; convert_later_weights(args, lds, ib_ * NWAVES + wave, nb_ * NWAVES, wave, lane); p0_tables(args, ib_ * NWAVES + wave, nb_ * NWAVES, lane); }
    }
    SEAM(1);
    if (IN(2)) REP(2) {
        for (int task = vcu; task < 256; task += G) ssm_task<false>(args, (task >> 5) * 8 + wave, task & 31, (task & 31) + 32, lds + wave * 16384, lane);
        for (int unit = vcu; unit < 256; unit += G) { const int QB = unit >> 2, kvh = unit & 3;
            __syncthreads();
            attn_stage(args, lds, QB, kvh, tid);
            __syncthreads();
#pragma unroll 1
            for (int r = 0; r < 2; ++r) { const int tk = wave + 8 * r; attn_task(args, lds, QB, tk & 3, kvh * 4 + (tk >> 2), lane); } }
    }
    SEAM(2);
    if (IN(3)) REP(3) { for (int task = vcu; task < 256; task += G) ssm_task<true>(args, (task >> 5) * 8 + wave, task & 31, (task & 31) + 32, lds + wave * 16384, lane); }
    SEAM(3);
    if (IN(4)) REP(4) {
        SchedGrid S{(const char*)(ws + WS_Z), (const char*)(ws + WS_WGLU), nullptr, nullptr, 32, 8, 1, 1024, G, bx};
        EpiGlu E{(bf16*)(ws + WS_G), (const float*)args.in[I_BGLU]};
        pg8::gemm_phase<EpiGlu, SchedGrid, true, true, false>(lds, 1024, S, E);
    }
    SEAM(4);
    if (IN(5)) REP(5) {
        if (G == 256) {
            SchedGrid S{(const char*)(ws + WS_G), (const char*)(ws + WS_WBRS), (const char*)(ws + WS_O), (const char*)(ws + WS_WBRA), 32, 8, 2, 1024, G, bx};
            EpiMix E{(bf16*)(ws + WS_MIX), (const bf16*)(ws + WS_GATES)};
            pg8::gemm_phase<EpiMix, SchedGrid, true, true, false>(lds, 1024, S, E);
        }
    }
    SEAM(5);
    if (IN(6)) REP(6) {
        SchedGrid S{(const char*)(ws + WS_MIX), (const char*)(ws + WS_WO), nullptr, nullptr, 32, 8, 1, 2048, G, bx};
        EpiRes E{(const float*)args.in[I_X], (float*)(ws + WS_H1)};
        pg8::gemm_phase<EpiRes, SchedGrid, true, true, false>(lds, 2048, S, E);
    }
    SEAM(6);
    if (IN(7)) { for (int tb = vcu; tb < T / 32; tb += G) router_block(args, lds, tb * 32, tid, wave, lane); }
    SEAM(7);
    if (IN(8) || IN(9)) {
        const int* cnt = (const int*)(ctl + CW_CNT);
        if (tid < 64) MISC[96 + tid] = (unsigned)((cnt[tid] + moe::BM - 1) / moe::BM);
        __syncthreads();
        if (tid == 0) { unsigned acc = 0; for (int e = 0; e < 64; ++e) { MISC[16 + e] = acc; acc += MISC[96 + e]; } MISC[16 + 64] = acc; }
        __syncthreads();
        const volatile LAS int* pref = (const volatile LAS int*)(MISC + 16);
        if (IN(8)) REP(8) moe::gemm<true>(lds, args, pref, G, bx);
        SEAM(8);
        if (IN(9)) REP(9) moe::gemm<false>(lds, args, pref, G, bx);
    }
    SEAM(9);
    if (IN(10)) REP(10) final_rows(args, gw, NGW, lane);
#undef IN
#undef SEAM
}

extern "C" void kernel_launch(void* const* d_in, const int* in_sizes, int n_in, void* d_out, int out_size, void* d_ws, size_t ws_size, hipStream_t stream) {
    static int grid = 0;
    if (grid == 0) {
        if (n_in != 28 || out_size != T * D || ws_size < WS_END) { fprintf(stderr, "kernel_launch: expected 28 inputs, %d outputs, >= %zu bytes of workspace; got %d, %d, %zu\n", T * D, (size_t)WS_END, n_in, out_size, ws_size); grid = -1; return; }
        int dev = 0, cus = 0, per_cu = 0;
        if (hipGetDevice(&dev) != hipSuccess || hipDeviceGetAttribute(&cus, hipDeviceAttributeMultiprocessorCount, dev) != hipSuccess) { grid = -1; return; }
        if (hipFuncSetAttribute((const void*)mega_fwd, hipFuncAttributeMaxDynamicSharedMemorySize, LDS_BYTES) != hipSuccess) { fprintf(stderr, "kernel_launch: hipFuncSetAttribute failed\n"); grid = -1; return; }
        if (hipOccupancyMaxActiveBlocksPerMultiprocessor(&per_cu, (const void*)mega_fwd, NWAVES * 64, LDS_BYTES) != hipSuccess || per_cu < 1) fprintf(stderr, "kernel_launch: occupancy query reports %d workgroups per CU\n", per_cu);
        (void)hipGetLastError();
        grid = cus;
        if (grid != 256) fprintf(stderr, "kernel_launch: %d CUs; built for 256\n", grid);
    }
    if (grid < 0) return;
    if (hipMemsetAsync((char*)d_ws + WS_CTL, 0, CTL_ZERO_BYTES, stream) != hipSuccess) { fprintf(stderr, "kernel_launch: hipMemsetAsync failed\n"); return; }
    Args a{};
    for (int i = 0; i < 28; ++i) a.in[i] = d_in[i];
    a.out = (float*)d_out; a.ws = (unsigned char*)d_ws;
    for (int li = 0; li < N_LAUNCHES; ++li) {
        a.ph_lo = (N_LAUNCHES == 1) ? 0 : li; a.ph_hi = (N_LAUNCHES == 1) ? N_PHASES : li + 1;
        hipLaunchKernelGGL(mega_fwd, dim3(grid), dim3(NWAVES * 64), LDS_BYTES, stream, a);
        const hipError_t le = hipPeekAtLastError();
        if (le != hipSuccess) { fprintf(stderr, "kernel_launch: launch %d failed: %s\n", li, hipGetErrorName(le)); break; }
    }
}
```

```cpp
#include <hip/hip_runtime.h>
#include <cstdio>
#include <cstdint>

#define LAS __attribute__((address_space(3)))
#define GAS __attribute__((address_space(1)))
typedef unsigned short bf16;
typedef short bf16x8 __attribute__((ext_vector_type(8)));
typedef float f32x2 __attribute__((ext_vector_type(2)));
typedef float f32x4 __attribute__((ext_vector_type(4)));
typedef float f32x16 __attribute__((ext_vector_type(16)));
typedef unsigned u32x2 __attribute__((ext_vector_type(2)));
typedef unsigned u32x4 __attribute__((ext_vector_type(4)));
typedef __bf16 bf16x2n __attribute__((ext_vector_type(2)));

#ifndef MK_N_LAUNCHES
#define MK_N_LAUNCHES 1
#endif
constexpr int N_PHASES = 11;
#ifndef PHMASK
#define PHMASK 0x7ff
#endif
#ifndef PROBE_PH
#define PROBE_PH -1
#endif
#define REP(k) for (int rep_ = 0; rep_ < ((k) == PROBE_PH ? 2 : 1); ++rep_)
constexpr int N_LAUNCHES = MK_N_LAUNCHES;
constexpr int NWAVES = 8;

constexpr int T = 8192, D = 2048, INW = 6656;
constexpr int SSMW = 1024, SGRP = 64, SCH = 16, SST = 64;
constexpr int NQH = 16, NKVH = 4, HD = 64;
constexpr int NEXP = 64, DE = 512;
constexpr int LSEG = 128, NSEG = T / LSEG;
constexpr float EPS = 1e-6f;
constexpr int LIST_CAP = 8192;

constexpr size_t MiB = 1u << 20;
constexpr size_t WS_CTL = 0, CTL_ZERO_BYTES = 1 * MiB;
constexpr size_t WS_TAB = 1 * MiB;
constexpr size_t TAB_ABAR = 0, TAB_ABARL = 32768, TAB_BB = 65536, TAB_CM = 65536 + 262144;
constexpr size_t WS_E = 2 * MiB;
constexpr size_t WS_WIN = 4 * MiB;
constexpr size_t WS_WGLU = 30 * MiB;
constexpr size_t WS_WBRS = 34 * MiB;
constexpr size_t WS_WBRA = 38 * MiB;
constexpr size_t WS_WO = 42 * MiB;
constexpr size_t WS_XN = 50 * MiB;
constexpr size_t WS_U = 82 * MiB;
constexpr size_t WS_Q = 98 * MiB;
constexpr size_t WS_K = 114 * MiB;
constexpr size_t WS_VT = 118 * MiB;
constexpr size_t WS_GATES = 122 * MiB;
constexpr size_t WS_Z = 186 * MiB;
constexpr size_t WS_G = 202 * MiB;
constexpr size_t WS_O = 218 * MiB;
constexpr size_t WS_MIX = 234 * MiB;
constexpr size_t WS_H1 = 266 * MiB;
constexpr size_t WS_HN = 330 * MiB;
constexpr size_t WS_LISTA = 362 * MiB;
constexpr size_t WS_LISTW = 364 * MiB;
constexpr size_t WS_Y2 = 366 * MiB;
constexpr size_t WS_HB = 430 * MiB;
constexpr size_t WS_WR = 472 * MiB;
constexpr size_t WS_END = 504 * MiB;
constexpr int CW_BAR = 4096;
constexpr int CW_CNT = 16384;

constexpr int LDS_BYTES = 163840;
constexpr int MISC_OFF = LDS_BYTES - 1024;

#define LDS_WAIT() asm volatile("s_waitcnt lgkmcnt(0)" ::: "memory")
#define MFMA_SETTLE() do { __builtin_amdgcn_sched_barrier(0); asm volatile("s_nop 15\n\ts_nop 15\n\ts_nop 15\n\ts_nop 15" ::: "memory"); __builtin_amdgcn_sched_barrier(0); } while (0)
#define VM_WAIT() asm volatile("s_waitcnt vmcnt(0)" ::: "memory")
__device__ __forceinline__ unsigned pk2(float lo, float hi) { f32x2 v = {lo, hi}; return __builtin_bit_cast(unsigned, __builtin_convertvector(v, bf16x2n)); }
__device__ __forceinline__ float bf_lo(unsigned u) { return __builtin_bit_cast(float, u << 16); }
__device__ __forceinline__ float bf_hi(unsigned u) { return __builtin_bit_cast(float, u & 0xffff0000u); }
__device__ __forceinline__ float wave_sum(float v) {
#pragma unroll
    for (int o = 1; o < 64; o <<= 1) v += __shfl_xor(v, o);
    return v;
}
__device__ __forceinline__ float fast_exp(float x) { return __builtin_amdgcn_exp2f(x * 1.4426950408889634f); }
__device__ __forceinline__ float sigmoidf_(float x) { return __builtin_amdgcn_rcpf(1.0f + fast_exp(-x)); }

namespace pg8 {
constexpr int BM = 256, BK = 64, HALF = 128, HTB = HALF * BK * 2, STAGE_BYTES = 8 * HTB, NXCD = 8, WGM = 8;
__host__ __device__ __forceinline__ int lds_byte(int r, int c) { const int st = (r >> 4) * 2 + (c >> 5), rr = r & 15, cc = c & 31, ob = rr * 64 + cc * 2; return st * 1024 + (ob ^ (((ob >> 9) & 1) << 5)); }
__host__ __device__ __forceinline__ void stage_rc(int b, int& R, int& C) { const int st = b / 1024, sb = b % 1024, swz = sb ^ (((sb >> 9) & 1) << 5); R = (st >> 1) * 16 + swz / 64; C = (st & 1) * 32 + (swz % 64) / 2; }
__host__ __device__ __forceinline__ int perm32(int rho) { const int n = rho >> 4, i = rho & 15; return 8 * (i >> 2) + 4 * n + (i & 3); }

struct Unit { int pm, pn, aux, aux2; const char* a; const char* b; };

__device__ __forceinline__ void grid_order(int L, int nM, int nN, int& pm, int& pn) {
    const int nwg = nM * nN; int wgid = L;
    { const int q = nwg / NXCD, r = nwg % NXCD, xcd = wgid % NXCD, off = wgid / NXCD; wgid = (xcd < r ? xcd * (q + 1) : r * (q + 1) + (xcd - r) * q) + off; }
    const int nig = WGM * nN, gid = wgid / nig, fm = gid * WGM, gsz = (nM - fm) < WGM ? (nM - fm) : WGM;
    pm = fm + ((wgid % nig) % gsz); pn = (wgid % nig) / gsz;
}
__device__ __forceinline__ int xcd_remap(int L, int nwg) { const int q = nwg / NXCD, r = nwg % NXCD, xcd = L % NXCD, off = L / NXCD; return (xcd < r ? xcd * (q + 1) : r * (q + 1) + (xcd - r) * q) + off; }

template <class Epi, class Sched, bool ALIGN_EPI, bool SP2, bool GATHER>
__device__ __forceinline__ void gemm_phase(LAS unsigned char* lds, const int K, const Sched& S, const Epi& E) {
    const int tid = threadIdx.x, wid = __builtin_amdgcn_readfirstlane(tid >> 6), lane = tid & 63, wr = wid >> 2, wc = wid & 3, fr = lane & 15, fq = lane >> 4;
    const int nt = K / BK;
    unsigned voffA[2], voffB[2]; int RA[2], CA[2];
#pragma unroll
    for (int i = 0; i < 2; ++i) { int R, C; stage_rc(tid * 16 + i * 8192, R, C); const int Rb = Epi::PERM ? ((R & ~31) + perm32(R & 31)) : R;
        RA[i] = R; CA[i] = C; voffA[i] = (unsigned)(R * K + C) * 2u; voffB[i] = (unsigned)(Rb * K + C) * 2u; }
    const size_t kstep = (size_t)(BK * 2);
    const size_t hstep = (size_t)HALF * K * 2;
    const unsigned ldsw = (unsigned)wid * 1024u;
    const int aoff = lds_byte(wr * 64 + fr, fq * 8), boff = lds_byte(wc * 32 + fr, fq * 8);
    unsigned gC[2][2], gN[2][2];
#define PG8_SA(b, h) (((b) * 2 + (h)) * HTB)
#define PG8_SB(b, h) ((4 + (b) * 2 + (h)) * HTB)
#define PG8_GLDS(src, dstoff) __builtin_amdgcn_global_load_lds((const unsigned*)(src), (LAS unsigned*)(lds + (dstoff)), 16, 0, 0)
#define PG8_STAGE_B(bufoff, gbase) do { PG8_GLDS((const char*)(gbase) + voffB[0], (bufoff) + ldsw); PG8_GLDS((const char*)(gbase) + voffB[1], (bufoff) + ldsw + 8192); } while (0)
#define PG8_STAGE_A(bufoff, gbase, h, usen) do { if constexpr (GATHER) { const unsigned o0_ = (usen) ? gN[h][0] : gC[h][0], o1_ = (usen) ? gN[h][1] : gC[h][1]; \
            PG8_GLDS((const char*)(gbase) + o0_, (bufoff) + ldsw); PG8_GLDS((const char*)(gbase) + o1_, (bufoff) + ldsw + 8192); } \
        else { PG8_GLDS((const char*)(gbase) + (h) * hstep + voffA[0], (bufoff) + ldsw); PG8_GLDS((const char*)(gbase) + (h) * hstep + voffA[1], (bufoff) + ldsw + 8192); } } while (0)
#define PG8_LDA(dst, b, h) do { _Pragma("unroll") for (int m = 0; m < 4; ++m) _Pragma("unroll") for (int k = 0; k < 2; ++k) dst[m][k] = *(const LAS bf16x8*)(lds + PG8_SA(b, h) + aoff + m * 2048 + k * 1024); } while (0)
#define PG8_LDB(dst, b, h) do { _Pragma("unroll") for (int n = 0; n < 2; ++n) _Pragma("unroll") for (int k = 0; k < 2; ++k) dst[n][k] = *(const LAS bf16x8*)(lds + PG8_SB(b, h) + boff + n * 2048 + k * 1024); } while (0)
#define PG8_MMA(ai, bj, At, Bt) do { __builtin_amdgcn_s_setprio(1); _Pragma("unroll") for (int m = 0; m < 4; ++m) _Pragma("unroll") for (int n = 0; n < 2; ++n) _Pragma("unroll") for (int k = 0; k < 2; ++k) \
        acc[ai][bj][m][n] = __builtin_amdgcn_mfma_f32_16x16x32_bf16(Bt[n][k], At[m][k], acc[ai][bj][m][n], 0, 0, 0); __builtin_amdgcn_s_setprio(0); } while (0)
#define PG8_WAIT_V(n) asm volatile("s_waitcnt vmcnt(" #n ")" ::: "memory")
#define PG8_WAIT_L(n) asm volatile("s_waitcnt lgkmcnt(" #n ")" ::: "memory")
#define PG8_BAR __builtin_amdgcn_s_barrier()
#define PG8_SCHED __builtin_amdgcn_sched_barrier(0)
    Unit cur, nxt; int ui = 0;
    if (!S.next(0, cur)) return;
    if constexpr (GATHER) S.gather(cur, gC, RA, CA);
    f32x4 acc[2][2][4][2];
#pragma unroll
    for (int a = 0; a < 2; ++a)
#pragma unroll
        for (int b = 0; b < 2; ++b)
#pragma unroll
            for (int m = 0; m < 4; ++m)
#pragma unroll
                for (int n = 0; n < 2; ++n) acc[a][b][m][n] = (f32x4){0.f, 0.f, 0.f, 0.f};
    bf16x8 At[4][2], B0[2][2], B1[2][2];
    const char* cA = cur.a; const char* cB = cur.b;
    static_assert(SP2, "only the two-super-phase loop is kept");
    PG8_STAGE_B(PG8_SB(0, 0), cB); PG8_STAGE_B(PG8_SB(0, 1), cB + hstep); PG8_STAGE_A(PG8_SA(0, 0), cA, 0, false); PG8_STAGE_A(PG8_SA(0, 1), cA, 1, false);
    if (wr == 1) PG8_BAR;
    PG8_WAIT_V(2); PG8_BAR;
    PG8_STAGE_B(PG8_SB(1, 0), cB + kstep); PG8_STAGE_A(PG8_SA(1, 0), cA + kstep, 0, false); PG8_STAGE_B(PG8_SB(1, 1), cB + hstep + kstep);
    PG8_WAIT_V(6); PG8_BAR;
    for (;;) {
        const bool has_next = S.next(ui + 1, nxt);
        if constexpr (GATHER) { if (has_next) S.gather(nxt, gN, RA, CA); else {
#pragma unroll
            for (int h = 0; h < 2; ++h) { gN[h][0] = gC[h][0]; gN[h][1] = gC[h][1]; } } }
        const char* nA = has_next ? nxt.a : cA; const char* nB = has_next ? nxt.b : cB;
        for (int t = 0; t < nt; t += 2) {
            const bool last = (t == nt - 2);
            const char* a1 = cA + (size_t)(t + 1) * kstep;
            const char* a2 = last ? nA : cA + (size_t)(t + 2) * kstep; const char* b2 = last ? nB : cB + (size_t)(t + 2) * kstep;
            const char* a3 = a2 + kstep; const char* b3 = b2 + kstep;
            PG8_LDB(B0, 0, 0); PG8_LDB(B1, 0, 1); PG8_SCHED; PG8_LDA(At, 0, 0); PG8_STAGE_A(PG8_SA(1, 1), a1, 1, false);
            PG8_WAIT_V(8); PG8_WAIT_L(0); PG8_BAR; PG8_MMA(0, 0, At, B0); PG8_MMA(0, 1, At, B1); PG8_BAR; PG8_SCHED;
            PG8_LDA(At, 0, 1); PG8_STAGE_B(PG8_SB(0, 0), b2); PG8_STAGE_B(PG8_SB(0, 1), b2 + hstep); PG8_STAGE_A(PG8_SA(0, 0), a2, 0, last);
            PG8_WAIT_V(8); PG8_WAIT_L(0); PG8_BAR; PG8_MMA(1, 0, At, B0); PG8_MMA(1, 1, At, B1); PG8_BAR; PG8_SCHED;
            PG8_LDB(B0, 1, 0); PG8_LDB(B1, 1, 1); PG8_SCHED; PG8_LDA(At, 1, 0); PG8_STAGE_A(PG8_SA(0, 1), a2, 1, last);
            PG8_WAIT_V(8); PG8_WAIT_L(0); PG8_BAR; PG8_MMA(0, 0, At, B0); PG8_MMA(0, 1, At, B1); PG8_BAR; PG8_SCHED;
            PG8_LDA(At, 1, 1); PG8_STAGE_B(PG8_SB(1, 0), b3); PG8_STAGE_B(PG8_SB(1, 1), b3 + hstep); PG8_STAGE_A(PG8_SA(1, 0), a3, 0, last);
            PG8_WAIT_V(8); PG8_WAIT_L(0); PG8_BAR; PG8_MMA(1, 0, At, B0); PG8_MMA(1, 1, At, B1); PG8_BAR; PG8_SCHED;
        }
        if constexpr (ALIGN_EPI) { if (wr == 0) PG8_BAR; }
        MFMA_SETTLE();
        E(acc, cur, wr, wc, fr, fq);
        if (!has_next) break;
        if (!(Epi::KEEP && cur.aux == 0)) {
#pragma unroll
        for (int a = 0; a < 2; ++a)
#pragma unroll
            for (int b = 0; b < 2; ++b)
#pragma unroll
                for (int m = 0; m < 4; ++m)
#pragma unroll
                    for (int n = 0; n < 2; ++n) acc[a][b][m][n] = (f32x4){0.f, 0.f, 0.f, 0.f};
        }
        cur = nxt; cA = nA; cB = nB; ++ui;
        if constexpr (GATHER) {
#pragma unroll
            for (int h = 0; h < 2; ++h) { gC[h][0] = gN[h][0]; gC[h][1] = gN[h][1]; } }
        if constexpr (ALIGN_EPI) { if (wr == 1) PG8_BAR; }
    }
    PG8_WAIT_V(0);
    if constexpr (!ALIGN_EPI) { if (wr == 0) PG8_BAR; }
    PG8_BAR;
#undef PG8_SA
#undef PG8_SB
#undef PG8_GLDS
#undef PG8_STAGE_A
#undef PG8_STAGE_B
#undef PG8_LDA
#undef PG8_LDB
#undef PG8_MMA
#undef PG8_WAIT_V
#undef PG8_WAIT_L
#undef PG8_BAR
#undef PG8_SCHED
}
}

#define XB_TMO      128
#define XB_XCNT(j)  (256  + 64 * (j))
#define XB_XSUB(j)  (1280 + 64 * (j))
#define XB_XGEN(j)  (2304 + 64 * (j))
#define XB_TOP      3328
#define XB_TOPGEN   3392
#define XCD_BAR_WORDS 3456
#define XB_SPIN_CAP (1u << 18)
__device__ __forceinline__ unsigned xb_ld(unsigned* p)              { return __hip_atomic_load(p, __ATOMIC_RELAXED, __HIP_MEMORY_SCOPE_AGENT); }
__device__ __forceinline__ unsigned xb_add(unsigned* p, unsigned v) { return __hip_atomic_fetch_add(p, v, __ATOMIC_RELAXED, __HIP_MEMORY_SCOPE_AGENT); }
__device__ __forceinline__ unsigned xb_xcc_id() { return (unsigned)__builtin_amdgcn_s_getreg((3 << 11) | 20) & 0xFu; }
#define XB_SPIN(cond, bar) do { unsigned _sp = 0; while (cond) { __builtin_amdgcn_s_sleep(1); \
    if ((++_sp & 255u) == 0u) { if (xb_ld(&(bar)[XB_TMO])) break; if (_sp > XB_SPIN_CAP) { atomicAdd(&(bar)[XB_TMO], 1u); break; } } } } while (0)
struct XcdBarrier { unsigned* bar; unsigned x; volatile LAS unsigned* st; };
__device__ __forceinline__ XcdBarrier xcd_barrier_post(unsigned* bar, volatile LAS unsigned* st) {
    XcdBarrier b; b.bar = bar; b.x = xb_xcc_id(); b.st = st;
    if (threadIdx.x == 0) (void)xb_add(&bar[XB_XCNT(b.x)], 1u);
    return b;
}
__device__ __forceinline__ void xcd_barrier_complete(unsigned* bar, unsigned x, unsigned& nloc, unsigned& nx) {
    const unsigned G = gridDim.x * gridDim.y * gridDim.z;
    unsigned sum, cnt, mine, sp = 0u;
    for (;;) {
        sum = 0u; cnt = 0u; mine = 0u;
#pragma unroll
        for (unsigned j = 0; j < 16; ++j) { const unsigned c = xb_ld(&bar[XB_XCNT(j)]); sum += c; cnt += (c > 0u) ? 1u : 0u; mine = (j == x) ? c : mine; }
        if (sum == G) break;
        __builtin_amdgcn_s_sleep(1);
        if ((++sp & 255u) == 0u) { if (xb_ld(&bar[XB_TMO])) break; if (sp > XB_SPIN_CAP) { atomicAdd(&bar[XB_TMO], 1u); break; } }
    }
    nloc = mine > 0u ? mine : 1u; nx = cnt > 0u ? cnt : 1u;
}
__device__ __forceinline__ void xcd_barrier(const XcdBarrier& b) {
    asm volatile("s_waitcnt vmcnt(0)" ::: "memory");
    __syncthreads();
    if (threadIdx.x == 0) {
        unsigned* bar = b.bar;
        __builtin_amdgcn_s_waitcnt(0);
        unsigned nloc = b.st[0], nx = b.st[1];
        if (nloc == 0u) { xcd_barrier_complete(bar, b.x, nloc, nx); b.st[0] = nloc; b.st[1] = nx; }
        const unsigned old = xb_add(&bar[XB_XSUB(b.x)], 1u);
        const unsigned gen = old / nloc;
        if (old + 1u == (gen + 1u) * nloc) {
            __builtin_amdgcn_fence(__ATOMIC_RELEASE, "agent");
            asm volatile("s_waitcnt vmcnt(0)" ::: "memory");
            const unsigned og = xb_add(&bar[XB_TOP], 1u);
            const unsigned tg = og / nx;
            if (og + 1u == (tg + 1u) * nx) xb_add(&bar[XB_TOPGEN], 1u);
            else XB_SPIN(xb_ld(&bar[XB_TOPGEN]) == tg, bar);
            __builtin_amdgcn_fence(__ATOMIC_ACQUIRE, "agent");
            xb_add(&bar[XB_XGEN(b.x)], 1u);
            asm volatile("s_waitcnt vmcnt(0)" ::: "memory");
        } else {
            XB_SPIN(xb_ld(&bar[XB_XGEN(b.x)]) == gen, bar);
            __builtin_amdgcn_fence(__ATOMIC_ACQUIRE, "agent");
            asm volatile("s_waitcnt vmcnt(0)" ::: "memory");
        }
    }
    __syncthreads();
}

struct Args { const void* in[28]; float* out; unsigned char* ws; int ph_lo, ph_hi; };
enum { I_X = 0, I_POS, I_NMG, I_WIN, I_BIN, I_ARE, I_AIM, I_LDT, I_BRE, I_BIM, I_CRE, I_CIM, I_SD, I_WGLU, I_BGLU, I_WBRS, I_SINK, I_WBRA, I_WO, I_NFG, I_WRG, I_BRG, I_WRE, I_BRE2, I_WEG, I_WEU, I_WED, I_NFIN };

struct SchedP1 {
    const char* XN; const char* WT; int G, c;
    __device__ __forceinline__ bool next(int i, pg8::Unit& u) const {
        const int L = i * G + c; if (L >= 32 * 26) return false;
        int pm, pn; pg8::grid_order(L, 32, 26, pm, pn);
        const size_t tstep = (size_t)256 * D * 2;
        if (pn == 9) { u.pm = 0; u.pn = pm; u.aux = 3; u.a = WT + 9 * tstep; u.b = XN + (size_t)pm * tstep; }
        else { u.pm = pm; u.pn = pn; u.aux = pn < 4 ? 0 : (pn < 8 ? 1 : (pn == 8 ? 2 : 4)); u.a = XN + (size_t)pm * tstep; u.b = WT + (size_t)pn * tstep; }
        u.aux2 = 0; return true;
    }
};
__constant__ double c_rope_rev[8] = {0.15915494309189535, 0.03086376340470123, 0.005985185712713705, 0.001160663641240061,
                                     0.00022507907903927653, 4.364795279280289e-05, 8.464330808241401e-06, 1.6414262627950345e-06};
struct EpiP1 {
    static constexpr bool KEEP = false; static constexpr bool PERM = true;
    bf16 *U, *Q, *Kb, *VT, *GATES; const float* bias; const int* pos;
    __device__ __forceinline__ void operator()(f32x4 (&acc)[2][2][4][2], const pg8::Unit& u, int wr, int wc, int fr, int fq) const {
        const int type = u.aux;
        const int row0 = u.pm * 256 + wr * 64 + fr, lc0 = wc * 32 + 8 * fq;
        if (type == 3) {
#pragma unroll
            for (int ai = 0; ai < 2; ++ai)
#pragma unroll
                for (int m = 0; m < 4; ++m) { const int r = row0 + ai * 128 + m * 16; const float bv = bias[2304 + r]; bf16* rowp = VT + (size_t)r * T + u.pn * 256 + lc0;
#pragma unroll
                    for (int bj = 0; bj < 2; ++bj) { const f32x4 v0 = acc[ai][bj][m][0] + bv, v1 = acc[ai][bj][m][1] + bv;
                        u32x4 w; w.x = pk2(v0[0], v0[1]); w.y = pk2(v0[2], v0[3]); w.z = pk2(v1[0], v1[1]); w.w = pk2(v1[2], v1[3]);
                        *(u32x4*)(rowp + bj * 128) = w; } }
            return;
        }
        const int gc0 = u.pn * 256 + lc0;
        f32x4 bv[2][2];
#pragma unroll
        for (int bj = 0; bj < 2; ++bj)
#pragma unroll
            for (int n = 0; n < 2; ++n) bv[bj][n] = *(const f32x4*)(bias + gc0 + bj * 128 + 4 * n);
        bf16* base; int ldc, colb; float sc = 1.f;
        if (type == 0) { base = U; ldc = 1024; colb = gc0; }
        else if (type == 1) { base = Q; ldc = 1024; colb = gc0 - 1024; sc = 0.125f; }
        else if (type == 2) { base = Kb; ldc = 256; colb = gc0 - 2048; }
        else { base = GATES; ldc = 4096; colb = gc0 - 2560; }
        const bool rope = (type == 1 || type == 2) && ((wc & 1) == 0);
        int posv[2][4];
        if (rope) {
#pragma unroll
            for (int ai = 0; ai < 2; ++ai)
#pragma unroll
                for (int m = 0; m < 4; ++m) posv[ai][m] = pos[row0 + ai * 128 + m * 16];
        }
        asm volatile("" ::: "memory");
#pragma unroll
        for (int ai = 0; ai < 2; ++ai)
#pragma unroll
            for (int m = 0; m < 4; ++m) {
                const int r = row0 + ai * 128 + m * 16;
                f32x4 v[2][2];
#pragma unroll
                for (int bj = 0; bj < 2; ++bj)
#pragma unroll
                    for (int n = 0; n < 2; ++n) v[bj][n] = acc[ai][bj][m][n] + bv[bj][n];
                if (rope) {
                    const double p = (double)posv[ai][m];
#pragma unroll
                    for (int n = 0; n < 2; ++n) {
                        f32x4 cs, sn;
#pragma unroll
                        for (int i = 0; i < 4; ++i) { const double rev = p * c_rope_rev[4 * n + i]; const float fr_ = (float)(rev - __builtin_rint(rev));
                            cs[i] = __builtin_amdgcn_cosf(fr_); sn[i] = __builtin_amdgcn_sinf(fr_); }
#pragma unroll
                        for (int bj = 0; bj < 2; ++bj) { const f32x4 x = v[bj][n]; f32x4 o;
#pragma unroll
                            for (int i = 0; i < 4; ++i) { const float pv = __shfl_xor(x[i], 16); o[i] = fq == 0 ? x[i] * cs[i] - pv * sn[i] : (fq == 1 ? x[i] * cs[i] + pv * sn[i] : x[i]); }
                            v[bj][n] = o; }
                    }
                }
                bf16* rowp = base + (size_t)r * ldc + colb;
#pragma unroll
                for (int bj = 0; bj < 2; ++bj) { f32x4 v0 = v[bj][0], v1 = v[bj][1];
                    if (type == 4) {
#pragma unroll
                        for (int i = 0; i < 4; ++i) { v0[i] = sigmoidf_(v0[i]); v1[i] = sigmoidf_(v1[i]); } }
                    else { v0 = v0 * sc; v1 = v1 * sc; }
                    u32x4 w; w.x = pk2(v0[0], v0[1]); w.y = pk2(v0[2], v0[3]); w.z = pk2(v1[0], v1[1]); w.w = pk2(v1[2], v1[3]);
                    *(u32x4*)(rowp + bj * 128) = w; }
                asm volatile("" ::: "memory");
            }
    }
};

struct SchedGrid {
    const char* A0; const char* B0; const char* A1; const char* B1; int nM, nN, rounds, K, G, c;
    __device__ __forceinline__ bool next(int i, pg8::Unit& u) const {
        const int L = i * G + c, nwg = nM * nN; if (L >= nwg * rounds) return false;
        const int rd = L / nwg; int pm, pn; pg8::grid_order(L - rd * nwg, nM, nN, pm, pn);
        const size_t tstep = (size_t)256 * K * 2;
        u.pm = pm; u.pn = pn; u.aux = rd; u.aux2 = 0; u.a = (rd ? A1 : A0) + (size_t)pm * tstep; u.b = (rd ? B1 : B0) + (size_t)pn * tstep; return true;
    }
};
struct EpiGlu {
    static constexpr bool KEEP = false; static constexpr bool PERM = true;
    bf16* Gout; const float* bias;
    __device__ __forceinline__ void operator()(f32x4 (&acc)[2][2][4][2], const pg8::Unit& u, int wr, int wc, int fr, int fq) const {
        const int row0 = u.pm * 256 + wr * 64 + fr, j0 = u.pn * 128 + wc * 32 + 8 * fq;
        f32x4 ba[2], bb[2];
#pragma unroll
        for (int n = 0; n < 2; ++n) { ba[n] = *(const f32x4*)(bias + j0 + 4 * n); bb[n] = *(const f32x4*)(bias + 1024 + j0 + 4 * n); }
#pragma unroll
        for (int ai = 0; ai < 2; ++ai)
#pragma unroll
            for (int m = 0; m < 4; ++m) { f32x4 o[2];
#pragma unroll
                for (int n = 0; n < 2; ++n) { const f32x4 a = acc[ai][0][m][n] + ba[n], b = acc[ai][1][m][n] + bb[n];
#pragma unroll
                    for (int i = 0; i < 4; ++i) o[n][i] = a[i] * sigmoidf_(b[i]); }
                u32x4 w; w.x = pk2(o[0][0], o[0][1]); w.y = pk2(o[0][2], o[0][3]); w.z = pk2(o[1][0], o[1][1]); w.w = pk2(o[1][2], o[1][3]);
                *(u32x4*)(Gout + (size_t)(row0 + ai * 128 + m * 16) * 1024 + j0) = w; }
    }
};
struct EpiMix {
    static constexpr bool KEEP = true; static constexpr bool PERM = true;
    bf16* MIX; const bf16* GATES;
    __device__ __forceinline__ void operator()(f32x4 (&acc)[2][2][4][2], const pg8::Unit& u, int wr, int wc, int fr, int fq) const {
        const int row0 = u.pm * 256 + wr * 64 + fr, c0 = u.pn * 256 + wc * 32 + 8 * fq, rd = u.aux;
#pragma unroll
        for (int ai = 0; ai < 2; ++ai) {
            u32x4 g0[4][2], g1[4][2];
#pragma unroll
            for (int m = 0; m < 4; ++m) { const size_t r = (size_t)(row0 + ai * 128 + m * 16);
#pragma unroll
                for (int bj = 0; bj < 2; ++bj) { g1[m][bj] = *(const u32x4*)(GATES + r * 4096 + 2048 + c0 + bj * 128);
                    g0[m][bj] = rd ? (u32x4){0u, 0u, 0u, 0u} : *(const u32x4*)(GATES + r * 4096 + c0 + bj * 128); } }
            asm volatile("" ::: "memory");
#pragma unroll
            for (int m = 0; m < 4; ++m) { const size_t r = (size_t)(row0 + ai * 128 + m * 16);
#pragma unroll
                for (int bj = 0; bj < 2; ++bj) { const u32x4 a = g0[m][bj], b = g1[m][bj];
                    if (rd == 0) {
                        f32x4 r0, r1;
                        r0[0] = bf_lo(a.x) * __builtin_amdgcn_rcpf(fmaxf(bf_lo(b.x), 1e-30f)); r0[1] = bf_hi(a.x) * __builtin_amdgcn_rcpf(fmaxf(bf_hi(b.x), 1e-30f));
                        r0[2] = bf_lo(a.y) * __builtin_amdgcn_rcpf(fmaxf(bf_lo(b.y), 1e-30f)); r0[3] = bf_hi(a.y) * __builtin_amdgcn_rcpf(fmaxf(bf_hi(b.y), 1e-30f));
                        r1[0] = bf_lo(a.z) * __builtin_amdgcn_rcpf(fmaxf(bf_lo(b.z), 1e-30f)); r1[1] = bf_hi(a.z) * __builtin_amdgcn_rcpf(fmaxf(bf_hi(b.z), 1e-30f));
                        r1[2] = bf_lo(a.w) * __builtin_amdgcn_rcpf(fmaxf(bf_lo(b.w), 1e-30f)); r1[3] = bf_hi(a.w) * __builtin_amdgcn_rcpf(fmaxf(bf_hi(b.w), 1e-30f));
                        acc[ai][bj][m][0] = acc[ai][bj][m][0] * r0; acc[ai][bj][m][1] = acc[ai][bj][m][1] * r1;
                    } else {
                        const f32x4 a0 = acc[ai][bj][m][0], a1 = acc[ai][bj][m][1];
                        u32x4 w; w.x = pk2(a0[0] * bf_lo(b.x), a0[1] * bf_hi(b.x)); w.y = pk2(a0[2] * bf_lo(b.y), a0[3] * bf_hi(b.y));
                        w.z = pk2(a1[0] * bf_lo(b.z), a1[1] * bf_hi(b.z)); w.w = pk2(a1[2] * bf_lo(b.w), a1[3] * bf_hi(b.w));
                        *(u32x4*)(MIX + r * 2048 + c0 + bj * 128) = w; } } }
            asm volatile("" ::: "memory");
        }
    }
};
struct EpiRes {
    static constexpr bool KEEP = false; static constexpr bool PERM = false;
    const float* X; float* H1;
    __device__ __forceinline__ void operator()(f32x4 (&acc)[2][2][4][2], const pg8::Unit& u, int wr, int wc, int fr, int fq) const {
        const int row0 = u.pm * 256 + wr * 64 + fr, c0 = u.pn * 256 + wc * 32 + 4 * fq;
#pragma unroll
        for (int ai = 0; ai < 2; ++ai)
#pragma unroll
            for (int mp = 0; mp < 2; ++mp) {
                f32x4 xv[2][2][2];
#pragma unroll
                for (int mm = 0; mm < 2; ++mm) { const size_t off = (size_t)(row0 + ai * 128 + (2 * mp + mm) * 16) * D + c0;
#pragma unroll
                    for (int bj = 0; bj < 2; ++bj)
#pragma unroll
                        for (int n = 0; n < 2; ++n) xv[mm][bj][n] = *(const f32x4*)(X + off + bj * 128 + n * 16); }
                asm volatile("" ::: "memory");
#pragma unroll
                for (int mm = 0; mm < 2; ++mm) { const size_t off = (size_t)(row0 + ai * 128 + (2 * mp + mm) * 16) * D + c0;
#pragma unroll
                    for (int bj = 0; bj < 2; ++bj)
#pragma unroll
                        for (int n = 0; n < 2; ++n) *(f32x4*)(H1 + off + bj * 128 + n * 16) = xv[mm][bj][n] + acc[ai][bj][2 * mp + mm][n]; }
                asm volatile("" ::: "memory");
            }
    }
};
namespace moe {
constexpr int BM = 320, BN = 128, BK = 32, DB = 4;
constexpr int APAIR = BM * 128, BPAIR = BN * 128, B_OFF = 2 * APAIR;
static_assert(B_OFF + 2 * BPAIR <= MISC_OFF, "MoE buffers fit LDS");
struct Unit { int MT, nt, e, mtl; };
template <bool UP>
__device__ __forceinline__ void gemm(LAS unsigned char* lds, const Args& A, const volatile LAS int* pref, int G, int c) {
    constexpr int K = UP ? D : DE, NT = UP ? 8 : 16, nkt = K / BK, LDB = UP ? DE : D, APSTR = UP ? 128 : BM * 128;
    static_assert(nkt % 4 == 0, "ring alignment");
    const int tid = threadIdx.x, wid = __builtin_amdgcn_readfirstlane(tid >> 6), lane = tid & 63;
    unsigned char* ws = A.ws;
    const int* cnt = (const int*)((const unsigned*)(ws + WS_CTL) + CW_CNT); const int* lista = (const int*)(ws + WS_LISTA); const float* listw = (const float*)(ws + WS_LISTW);
    const int tot = pref[64] * NT;
    auto next = [&](int i, Unit& u) -> bool {
        int L = i * G + c; if (L >= tot) return false;
        L = pg8::xcd_remap(L, tot);
        const int MT = L / NT; int lo = 0, hi = 64; while (hi - lo > 1) { const int mid = (lo + hi) >> 1; if (pref[mid] <= MT) lo = mid; else hi = mid; }
        u.MT = __builtin_amdgcn_readfirstlane(MT); u.nt = __builtin_amdgcn_readfirstlane(L - MT * NT); u.e = __builtin_amdgcn_readfirstlane(lo); u.mtl = __builtin_amdgcn_readfirstlane(MT - pref[lo]); return true; };
    Unit cur, nxt; int ui = 0;
    if (!next(0, cur)) return;
    if (wid == 7) {
        const char* abase = (const char*)(ws + (UP ? WS_HN : WS_HB));
        auto setup = [&](const Unit& u, unsigned (&so)[40]) {
            const int n = cnt[u.e];
#pragma unroll
            for (int j = 0; j < 40; ++j) { const int row = 8 * j + (lane >> 3), slot = u.mtl * BM + row, lc = (lane & 7) ^ (row & 7);
                if (UP) { const int sl = slot < n ? slot : n - 1; const int tok = lista[u.e * LIST_CAP + (sl > 0 ? sl : 0)] >> 1;
                    so[j] = (unsigned)tok * (unsigned)(D * 2) + (unsigned)lc * 16u; }
                else so[j] = ((unsigned)u.MT * (unsigned)(DE / 64) * BM + (unsigned)row) * 128u + (unsigned)lc * 16u; }
        };
#define MOE_ISSUE_A(so, pr, pb) do { _Pragma("unroll") for (int j_ = 0; j_ < 40; ++j_) \
            __builtin_amdgcn_global_load_lds((const unsigned*)(abase + (so)[j_] + (size_t)(pr) * APSTR), (LAS unsigned*)(lds + (unsigned)(pb) * APAIR + (unsigned)j_ * 1024u), 16, 0, 0); } while (0)
        unsigned so[40];
        setup(cur, so);
        MOE_ISSUE_A(so, 0, 0);
        for (;;) {
            const bool has_next = next(ui + 1, nxt);
#pragma unroll 1
            for (int t = 0; t < nkt; t += 2) {
                asm volatile("s_waitcnt vmcnt(0)" ::: "memory");
                __builtin_amdgcn_s_barrier();
                asm volatile("" ::: "memory");
                if (t + 2 < nkt) MOE_ISSUE_A(so, (t + 2) >> 1, ((t >> 1) + 1) & 1);
                else { if (has_next) setup(nxt, so); MOE_ISSUE_A(so, 0, 0); }
                __builtin_amdgcn_s_barrier();
                asm volatile("" ::: "memory");
            }
            if (!has_next) break;
            cur = nxt; ++ui;
        }
        asm volatile("s_waitcnt vmcnt(0)" ::: "memory");
        __builtin_amdgcn_s_barrier();
#undef MOE_ISSUE_A
    } else if (wid >= 5) {
        const int kb = 2 * (wid - 5) + (lane >> 5), nq = lane & 31;
        auto bbase = [&](const Unit& u) -> const char* {
            if (UP) { const int grp = nq >> 2; const float* W = (const float*)A.in[(grp & 1) ? I_WEU : I_WEG] + (size_t)u.e * D * DE;
                return (const char*)(W + (size_t)(8 * kb) * DE + 64 * u.nt + (grp >> 1) * 16 + (nq & 3) * 4); }
            else { const float* W = (const float*)A.in[I_WED] + (size_t)u.e * DE * D; return (const char*)(W + (size_t)(8 * kb) * D + 128 * u.nt + nq * 4); } };
        auto loadB = [&](f32x4 (&v)[8], const char* base, int kt) {
#pragma unroll
            for (int j = 0; j < 8; ++j) v[j] = __builtin_nontemporal_load((const f32x4*)(base + ((size_t)kt * BK + j) * ((size_t)LDB * 4))); };
        const unsigned wr0 = (unsigned)(B_OFF + (4 * nq) * 128);
        auto writeB = [&](const f32x4 (&v)[8], int t) {
            const unsigned pb = (unsigned)((t >> 1) & 1) * BPAIR; const int ch = 4 * (t & 1) + kb;
#pragma unroll
            for (int i = 0; i < 4; ++i) { u32x4 w; w.x = pk2(v[0][i], v[1][i]); w.y = pk2(v[2][i], v[3][i]); w.z = pk2(v[4][i], v[5][i]); w.w = pk2(v[6][i], v[7][i]);
                *(LAS u32x4*)(lds + pb + wr0 + i * 128 + (unsigned)((ch ^ ((4 * nq + i) & 7)) * 16)) = w; } };
        f32x4 r0[8], r1[8], r2[8], r3[8];
        const char* bC = bbase(cur); const char* bN = bC;
        loadB(r0, bC, 0); loadB(r1, bC, 1); loadB(r2, bC, 2); loadB(r3, bC, 3);
        writeB(r0, 0); loadB(r0, bC, 4);
        LDS_WAIT();
        for (;;) {
            const bool has_next = next(ui + 1, nxt);
            bN = has_next ? bbase(nxt) : bC;
#pragma unroll 1
            for (int t0 = 0; t0 < nkt; t0 += 4) {
                const bool l1 = t0 + 5 >= nkt, l2 = t0 + 6 >= nkt, l3 = t0 + 7 >= nkt, l4 = t0 + 8 >= nkt;
                __builtin_amdgcn_s_barrier(); asm volatile("" ::: "memory");
                writeB(r1, t0 + 1); loadB(r1, l1 ? bN : bC, l1 ? t0 + 5 - nkt : t0 + 5); LDS_WAIT();
                __builtin_amdgcn_s_barrier(); asm volatile("" ::: "memory");
                writeB(r2, t0 + 2); loadB(r2, l2 ? bN : bC, l2 ? t0 + 6 - nkt : t0 + 6); LDS_WAIT();
                __builtin_amdgcn_s_barrier(); asm volatile("" ::: "memory");
                writeB(r3, t0 + 3); loadB(r3, l3 ? bN : bC, l3 ? t0 + 7 - nkt : t0 + 7); LDS_WAIT();
                __builtin_amdgcn_s_barrier(); asm volatile("" ::: "memory");
                writeB(r0, t0 + 4); loadB(r0, l4 ? bN : bC, l4 ? t0 + 8 - nkt : t0 + 8); LDS_WAIT();
            }
            if (!has_next) break;
            cur = nxt; ++ui; bC = bN;
        }
        __builtin_amdgcn_s_barrier();
    } else {
        const int fr = lane & 15, fq = lane >> 4;
        f32x4 acc[4][8];
#pragma unroll
        for (int rt = 0; rt < 4; ++rt)
#pragma unroll
            for (int ct = 0; ct < 8; ++ct) acc[rt][ct] = (f32x4){0.f, 0.f, 0.f, 0.f};
        const unsigned c_rd0 = (unsigned)(fr * 128 + ((fq ^ (fr & 7)) * 16));
        const unsigned c_rd1 = (unsigned)(fr * 128 + (((4 + fq) ^ (fr & 7)) * 16));
        for (;;) {
            const bool has_next = next(ui + 1, nxt);
#pragma unroll 1
            for (int t0 = 0; t0 < nkt; t0 += 4) {
#pragma unroll
                for (int s = 0; s < 4; ++s) {
                    __builtin_amdgcn_s_barrier();
                    asm volatile("" ::: "memory");
                    const unsigned rd = (s & 1) ? c_rd1 : c_rd0;
                    const unsigned sa = (unsigned)((s >> 1) & 1) * APAIR + (unsigned)(wid * 64 * 128) + rd, sb = (unsigned)B_OFF + (unsigned)((s >> 1) & 1) * BPAIR + rd;
                    bf16x8 af[4];
#pragma unroll
                    for (int rt = 0; rt < 4; ++rt) af[rt] = *(const LAS bf16x8*)(lds + sa + rt * 2048);
#pragma unroll
                    for (int ch = 0; ch < 2; ++ch) {
                        bf16x8 bfv[4];
#pragma unroll
                        for (int c4 = 0; c4 < 4; ++c4) bfv[c4] = *(const LAS bf16x8*)(lds + sb + (ch * 4 + c4) * 2048);
                        __builtin_amdgcn_s_setprio(1);
#pragma unroll
                        for (int rt = 0; rt < 4; ++rt)
#pragma unroll
                            for (int c4 = 0; c4 < 4; ++c4) acc[rt][ch * 4 + c4] = __builtin_amdgcn_mfma_f32_16x16x32_bf16(bfv[c4], af[rt], acc[rt][ch * 4 + c4], 0, 0, 0);
                        __builtin_amdgcn_s_setprio(0);
                    }
                    asm volatile("" ::: "memory");
                }
            }
            MFMA_SETTLE();
            if (UP) {
                bf16* HB = (bf16*)(ws + WS_HB);
#pragma unroll
                for (int rt = 0; rt < 4; ++rt) { bf16* rowp = HB + ((size_t)(cur.MT * NT + cur.nt) * BM + wid * 64 + rt * 16 + fr) * 64 + 4 * fq;
#pragma unroll
                    for (int cp = 0; cp < 4; ++cp) { const f32x4 g = acc[rt][2 * cp], uu = acc[rt][2 * cp + 1]; u32x2 w;
                        w.x = pk2(g[0] * sigmoidf_(g[0]) * uu[0], g[1] * sigmoidf_(g[1]) * uu[1]); w.y = pk2(g[2] * sigmoidf_(g[2]) * uu[2], g[3] * sigmoidf_(g[3]) * uu[3]);
                        *(u32x2*)(rowp + cp * 16) = w; } }
            } else {
                bf16* Y2 = (bf16*)(ws + WS_Y2); const int n = cnt[cur.e];
                int aid[4]; float wt[4];
#pragma unroll
                for (int rt = 0; rt < 4; ++rt) { const int slot = cur.mtl * BM + wid * 64 + rt * 16 + fr; const bool ok = slot < n; const int sl = ok ? slot : 0;
                    const int av = lista[cur.e * LIST_CAP + sl]; const float wv = listw[cur.e * LIST_CAP + sl]; aid[rt] = ok ? av : -1; wt[rt] = wv; }
                asm volatile("" ::: "memory");
#pragma unroll
                for (int rt = 0; rt < 4; ++rt) if (aid[rt] >= 0) { bf16* dst = Y2 + (size_t)aid[rt] * D + 128 * cur.nt + 4 * fq; const float w_ = wt[rt];
#pragma unroll
                    for (int ct = 0; ct < 8; ++ct) { const f32x4 v = acc[rt][ct] * w_; u32x2 w; w.x = pk2(v[0], v[1]); w.y = pk2(v[2], v[3]); *(u32x2*)(dst + ct * 16) = w; } }
            }
            if (!has_next) break;
#pragma unroll
            for (int rt = 0; rt < 4; ++rt)
#pragma unroll
                for (int ct = 0; ct < 8; ++ct) acc[rt][ct] = (f32x4){0.f, 0.f, 0.f, 0.f};
            cur = nxt; ++ui;
        }
        asm volatile("s_waitcnt vmcnt(0)" ::: "memory");
        __builtin_amdgcn_s_barrier();
    }
}
}

__device__ __forceinline__ void transpose_item(const float* W, int N, int K, bf16* WT, int k0, int n0, int drow0, LAS float* scr, int lane) {
#pragma unroll 8
    for (int i = 0; i < 32; ++i) { const int kk = 2 * i + (lane >> 5); scr[kk * 33 + (lane & 31)] = W[(size_t)(k0 + kk) * N + n0 + (lane & 31)]; }
    LDS_WAIT(); asm volatile("" ::: "memory");
    const int c = lane & 7;
#pragma unroll
    for (int j = 0; j < 4; ++j) { const int n = (lane >> 3) + 8 * j; const LAS float* s = scr + (8 * c) * 33 + n;
        u32x4 o; o.x = pk2(s[0 * 33], s[1 * 33]); o.y = pk2(s[2 * 33], s[3 * 33]); o.z = pk2(s[4 * 33], s[5 * 33]); o.w = pk2(s[6 * 33], s[7 * 33]);
        *(u32x4*)(WT + (size_t)(drow0 + n) * K + k0 + 8 * c) = o; }
    LDS_WAIT(); asm volatile("" ::: "memory");
}
__device__ __forceinline__ void sincos_d(double x, double& s, double& c) {
    const double n = __builtin_rint(x * 0.6366197723675814);
    double r = __builtin_fma(-n, 1.5707963267948966, x); r = __builtin_fma(-n, 6.123233995736766e-17, r);
    const double r2 = r * r;
    const double sp = r * (1.0 + r2 * (-1.0 / 6 + r2 * (1.0 / 120 + r2 * (-1.0 / 5040 + r2 * (1.0 / 362880 + r2 * (-1.0 / 39916800 + r2 * (1.0 / 6227020800.0 + r2 * (-1.0 / 1307674368000.0))))))));
    const double cp = 1.0 + r2 * (-0.5 + r2 * (1.0 / 24 + r2 * (-1.0 / 720 + r2 * (1.0 / 40320 + r2 * (-1.0 / 3628800 + r2 * (1.0 / 479001600 + r2 * (-1.0 / 87178291200.0)))))));
    const int q = ((int)n) & 3;
    s = (q == 0) ? sp : (q == 1) ? cp : (q == 2) ? -sp : -cp;
    c = (q == 0) ? cp : (q == 1) ? -sp : (q == 2) ? -cp : sp;
}
__device__ __forceinline__ double exp_d(double x) {
    const double k = __builtin_rint(x * 1.4426950408889634);
    double r = __builtin_fma(-k, 0.6931471805599453, x); r = __builtin_fma(-k, 2.3190468138462996e-17, r);
    double p = 1.0 / 479001600.0;
    p = p * r + 1.0 / 39916800.0; p = p * r + 1.0 / 3628800.0; p = p * r + 1.0 / 362880.0; p = p * r + 1.0 / 40320.0; p = p * r + 1.0 / 5040.0; p = p * r + 1.0 / 720.0;
    p = p * r + 1.0 / 120.0; p = p * r + 1.0 / 24.0; p = p * r + 1.0 / 6.0; p = p * r + 0.5; p = p * r + 1.0; p = p * r + 1.0;
    return __builtin_ldexp(p, (int)k);
}
constexpr int IT_WIN = 32 * 208, IT_GLU = 16 * 64, IT_BR = 16 * 64, IT_WO = 32 * 64, IT_EX = 64 * 512;
constexpr int IT_OTHERS = IT_GLU + 2 * IT_BR + IT_WO;
__device__ __forceinline__ void convert_later_weights(const Args& A, LAS unsigned char* lds, int gw, int NGW, int wave, int lane) {
    unsigned char* ws = A.ws;
    LAS float* scr = (LAS float*)(lds + wave * 16384);
    for (int it = gw; it < IT_OTHERS; it += NGW) {
        int r = it;
        if (r < IT_GLU) { const int kb = r / 64, nb = r % 64, n0 = 32 * nb, hf = n0 >> 10, j0 = n0 & 1023;
            transpose_item((const float*)A.in[I_WGLU], 2048, 1024, (bf16*)(ws + WS_WGLU), 64 * kb, n0, (j0 >> 7) * 256 + hf * 128 + (j0 & 127), scr, lane); continue; } r -= IT_GLU;
        if (r < IT_BR) { const int kb = r / 64, nb = r % 64; transpose_item((const float*)A.in[I_WBRS], 2048, 1024, (bf16*)(ws + WS_WBRS), 64 * kb, 32 * nb, 32 * nb, scr, lane); continue; } r -= IT_BR;
        if (r < IT_BR) { const int kb = r / 64, nb = r % 64; transpose_item((const float*)A.in[I_WBRA], 2048, 1024, (bf16*)(ws + WS_WBRA), 64 * kb, 32 * nb, 32 * nb, scr, lane); continue; } r -= IT_BR;
        { const int kb = r / 64, nb = r % 64; transpose_item((const float*)A.in[I_WO], 2048, 2048, (bf16*)(ws + WS_WO), 64 * kb, 32 * nb, 32 * nb, scr, lane); }
    }
}
__device__ __forceinline__ void p0_prologue(const Args& A, LAS unsigned char* lds, int gw, int NGW, int wave, int lane) {
    unsigned char* ws = A.ws;
    LAS float* scr = (LAS float*)(lds + wave * 16384);
    for (int it = gw; it < IT_WIN; it += NGW) { const int kb = it / 208, nb = it % 208; transpose_item((const float*)A.in[I_WIN], INW, D, (bf16*)(ws + WS_WIN), 64 * kb, 32 * nb, 32 * nb, scr, lane); }
    { const f32x4* gp = (const f32x4*)A.in[I_NMG] + lane; f32x4 gv[8];
#pragma unroll
      for (int j = 0; j < 8; ++j) gv[j] = gp[64 * j];
      for (int m = gw; m < T; m += 2 * NGW) {
        const int m2 = m + NGW < T ? m + NGW : m;
        const f32x4* xr = (const f32x4*)((const float*)A.in[I_X] + (size_t)m * D) + lane; const f32x4* xr2 = (const f32x4*)((const float*)A.in[I_X] + (size_t)m2 * D) + lane;
        f32x4 v[8], v2[8]; float s = 0.f, s2 = 0.f;
#pragma unroll
        for (int j = 0; j < 8; ++j) { v[j] = xr[64 * j]; v2[j] = xr2[64 * j]; }
#pragma unroll
        for (int j = 0; j < 8; ++j) { s += (v[j].x * v[j].x + v[j].y * v[j].y) + (v[j].z * v[j].z + v[j].w * v[j].w); s2 += (v2[j].x * v2[j].x + v2[j].y * v2[j].y) + (v2[j].z * v2[j].z + v2[j].w * v2[j].w); }
        const float rstd = 1.0f / sqrtf(wave_sum(s) * (1.0f / D) + EPS), rstd2 = 1.0f / sqrtf(wave_sum(s2) * (1.0f / D) + EPS);
        u32x2* o8 = (u32x2*)((bf16*)(ws + WS_XN) + (size_t)m * D) + lane; u32x2* o82 = (u32x2*)((bf16*)(ws + WS_XN) + (size_t)m2 * D) + lane;
#pragma unroll
        for (int j = 0; j < 8; ++j) { const f32x4 y = v[j] * rstd * gv[j]; u32x2 w; w.x = pk2(y.x, y.y); w.y = pk2(y.z, y.w); o8[64 * j] = w;
            const f32x4 y2 = v2[j] * rstd2 * gv[j]; u32x2 w2; w2.x = pk2(y2.x, y2.y); w2.y = pk2(y2.z, y2.w); o82[64 * j] = w2; }
      } }
}
__device__ __forceinline__ void p0_tables(const Args& A, int gw, int NGW, int lane) {
    unsigned char* ws = A.ws;
    for (int idx = gw * 64 + lane; idx < 80 * D; idx += NGW * 64) {
        const int k = idx / 80, r = idx - k * 80;
        const float v = r < 64 ? ((const float*)A.in[I_WRE])[(size_t)k * 64 + r] : (r < 72 ? ((const float*)A.in[I_WRG])[(size_t)k * 8 + (r - 64)] : 0.f);
        const unsigned hb = pk2(v, 0.f) & 0xffffu; const float hf = bf_lo(hb);
        bf16* wr = (bf16*)(ws + WS_WR);
        wr[(size_t)r * D + k] = (bf16)hb; wr[(size_t)(80 + r) * D + k] = (bf16)(pk2(v - hf, 0.f) & 0xffffu);
    }
    for (int idx = gw * 64 + lane; idx < SGRP * SST; idx += NGW * 64) {
        const int g = idx >> 6, p = idx & 63;
        const double lr = (double)fminf(((const float*)A.in[I_ARE])[idx], -1e-4f), li = (double)((const float*)A.in[I_AIM])[idx];
        const double dt = exp_d((double)((const float*)A.in[I_LDT])[g]);
        double s1, c1, sL, cL; sincos_d(li * dt, s1, c1); sincos_d(li * dt * LSEG, sL, cL);
        const double mag = exp_d(lr * dt), magL = exp_d(lr * dt * LSEG);
        const double are = mag * c1, aim = mag * s1;
        ((f32x2*)(ws + WS_TAB + TAB_ABAR))[idx] = (f32x2){(float)are, (float)aim};
        ((f32x2*)(ws + WS_TAB + TAB_ABARL))[idx] = (f32x2){(float)(magL * cL), (float)(magL * sL)};
        const double den = lr * lr + li * li, nr = are - 1.0, ni = aim;
        const double cre = (nr * lr + ni * li) / den, cim = (ni * lr - nr * li) / den;
        const float* br = (const float*)A.in[I_BRE] + (size_t)idx * SCH; const float* bi = (const float*)A.in[I_BIM] + (size_t)idx * SCH;
        bf16* bbr = (bf16*)(ws + WS_TAB + TAB_BB) + ((size_t)(g * 2 + 0) * 64 + p) * 16; bf16* bbi = (bf16*)(ws + WS_TAB + TAB_BB) + ((size_t)(g * 2 + 1) * 64 + p) * 16;
#pragma unroll
        for (int c = 0; c < 16; c += 2) {
            const double r0 = cre * br[c] - cim * bi[c], i0 = cre * bi[c] + cim * br[c], r1 = cre * br[c + 1] - cim * bi[c + 1], i1 = cre * bi[c + 1] + cim * br[c + 1];
            *(unsigned*)(bbr + c) = pk2((float)r0, (float)r1); *(unsigned*)(bbi + c) = pk2((float)i0, (float)i1); }
        const float* cr = (const float*)A.in[I_CRE] + (size_t)g * SCH * SST + p; const float* ci = (const float*)A.in[I_CIM] + (size_t)g * SCH * SST + p;
        bf16* cm = (bf16*)(ws + WS_TAB + TAB_CM) + (size_t)g * 16 * 128 + 2 * p;
#pragma unroll
        for (int c = 0; c < 16; ++c) *(unsigned*)(cm + c * 128) = pk2(cr[c * SST], -ci[c * SST]);
    }
}

__device__ __forceinline__ float gelu_tanh(float y) { const float w = 0.7978845608028654f * (y + 0.044715f * y * y * y); return y * __builtin_amdgcn_rcpf(1.0f + fast_exp(-2.0f * w)); }
template <bool PASS2>
__device__ __forceinline__ void ssm_task(const Args& A, int g, int s0, int s1, LAS unsigned char* xs, int lane) {
    unsigned char* ws = A.ws;
    const bf16* U = (const bf16*)(ws + WS_U);
    const int n = lane & 31, hi = lane >> 5, seg = hi ? s1 : s0;
    const int rb2 = (n >> 2) & 1, rstep = 4 * (n >> 3) + (n & 3);
    const bf16* up = U + (size_t)((rb2 ? s1 : s0) * LSEG + rstep) * SSMW + g * SCH + 8 * hi;
    bf16x8 bfr[2][2];
#pragma unroll
    for (int part = 0; part < 2; ++part)
#pragma unroll
        for (int q = 0; q < 2; ++q) bfr[part][q] = *(const bf16x8*)((const bf16*)(ws + WS_TAB + TAB_BB) + ((size_t)(g * 2 + part) * 64 + n + 32 * q) * 16 + 8 * hi);
    float ar[2], ai[2], xr[2] = {0.f, 0.f}, xi[2] = {0.f, 0.f};
#pragma unroll
    for (int q = 0; q < 2; ++q) { const f32x2 a = ((const f32x2*)(ws + WS_TAB + TAB_ABAR))[g * 64 + n + 32 * q]; ar[q] = a.x; ai[q] = a.y; }
    f32x2* Ebase = (f32x2*)(ws + WS_E) + (size_t)g * NSEG * 64;
    bf16x8 cmf[4];
    if constexpr (PASS2) {
        float lr[2], li[2];
#pragma unroll
        for (int q = 0; q < 2; ++q) { const f32x2 a = ((const f32x2*)(ws + WS_TAB + TAB_ABARL))[g * 64 + n + 32 * q]; lr[q] = a.x; li[q] = a.y; }
        for (int j0 = 0; j0 < s1; j0 += 16) {
            f32x2 e[16][2];
#pragma unroll
            for (int jj = 0; jj < 16; ++jj)
#pragma unroll
                for (int q = 0; q < 2; ++q) e[jj][q] = Ebase[(size_t)((j0 + jj) & 63) * 64 + n + 32 * q];
#pragma unroll
            for (int jj = 0; jj < 16; ++jj) if (j0 + jj < seg) {
#pragma unroll
                for (int q = 0; q < 2; ++q) { const float nr = lr[q] * xr[q] - li[q] * xi[q] + e[jj][q].x, ni = lr[q] * xi[q] + li[q] * xr[q] + e[jj][q].y; xr[q] = nr; xi[q] = ni; } }
        }
#pragma unroll
        for (int ks = 0; ks < 4; ++ks) cmf[ks] = *(const bf16x8*)((const bf16*)(ws + WS_TAB + TAB_CM) + ((size_t)g * 16 + (lane & 15)) * 128 + 32 * ks + 8 * (lane >> 4));
    }
    bf16x8 af_n = *(const bf16x8*)up;
    f32x4 dv = {0.f, 0.f, 0.f, 0.f};
    if constexpr (PASS2) dv = *(const f32x4*)((const float*)A.in[I_SD] + g * SCH + 4 * (lane >> 4));
    for (int blk = 0; blk < LSEG / 16; ++blk) {
        const bf16x8 af = af_n;
        if (blk + 1 < LSEG / 16) af_n = *(const bf16x8*)(up + (size_t)(blk + 1) * 16 * SSMW);
        u32x2 uvp[2];
        if constexpr (PASS2) {
#pragma unroll
            for (int hh = 0; hh < 2; ++hh) uvp[hh] = *(const u32x2*)(U + (size_t)((hh ? s1 : s0) * LSEG + blk * 16 + (lane & 15)) * SSMW + g * SCH + 4 * (lane >> 4)); }
        f32x16 br[2], bi[2];
        const f32x16 zero = {0.f, 0.f, 0.f, 0.f, 0.f, 0.f, 0.f, 0.f, 0.f, 0.f, 0.f, 0.f, 0.f, 0.f, 0.f, 0.f};
#pragma unroll
        for (int q = 0; q < 2; ++q) { br[q] = __builtin_amdgcn_mfma_f32_32x32x16_bf16(af, bfr[0][q], zero, 0, 0, 0); bi[q] = __builtin_amdgcn_mfma_f32_32x32x16_bf16(af, bfr[1][q], zero, 0, 0, 0); }
        MFMA_SETTLE();
#pragma unroll
        for (int i = 0; i < 16; ++i)
#pragma unroll
            for (int q = 0; q < 2; ++q) {
                const float nr = ar[q] * xr[q] - ai[q] * xi[q] + br[q][i], ni = ar[q] * xi[q] + ai[q] * xr[q] + bi[q][i]; xr[q] = nr; xi[q] = ni;
                if constexpr (PASS2) *(LAS unsigned*)(xs + ((hi * 16 + i) * 68 + n + 32 * q) * 4) = pk2(nr, ni);
            }
        if constexpr (PASS2) {
            LDS_WAIT(); __builtin_amdgcn_wave_barrier();
#pragma unroll
            for (int hh = 0; hh < 2; ++hh) {
                f32x4 y = {0.f, 0.f, 0.f, 0.f};
#pragma unroll
                for (int ks = 0; ks < 4; ++ks) { const bf16x8 xf = *(const LAS bf16x8*)(xs + (hh * 16 + (lane & 15)) * 272 + 64 * ks + 16 * (lane >> 4));
                    y = __builtin_amdgcn_mfma_f32_16x16x32_bf16(cmf[ks], xf, y, 0, 0, 0); }
                MFMA_SETTLE();
                const int t = (hh ? s1 : s0) * LSEG + blk * 16 + (lane & 15), ch = g * SCH + 4 * (lane >> 4);
                const u32x2 uv = uvp[hh];
                const float y0 = gelu_tanh(y[0] + dv[0] * bf_lo(uv.x)), y1 = gelu_tanh(y[1] + dv[1] * bf_hi(uv.x)), y2 = gelu_tanh(y[2] + dv[2] * bf_lo(uv.y)), y3 = gelu_tanh(y[3] + dv[3] * bf_hi(uv.y));
                u32x2 w; w.x = pk2(y0, y1); w.y = pk2(y2, y3);
                *(u32x2*)((bf16*)(ws + WS_Z) + (size_t)t * SSMW + ch) = w;
            }
            LDS_WAIT(); __builtin_amdgcn_wave_barrier();
        }
    }
    if constexpr (!PASS2) {
#pragma unroll
        for (int q = 0; q < 2; ++q) Ebase[(size_t)seg * 64 + n + 32 * q] = (f32x2){xr[q], xi[q]};
    }
}

constexpr int AT_KP = 144, AT_VP = 520, AT_VOFF = 256 * AT_KP;
__device__ __forceinline__ void attn_stage(const Args& A, LAS unsigned char* lds, int QB, int kvh, int tid) {
    unsigned char* ws = A.ws;
    const bf16* Kb = (const bf16*)(ws + WS_K); const bf16* VT = (const bf16*)(ws + WS_VT);
    const int kb0 = QB * 128 - 128;
    u32x4 kv[4], vv[4];
#pragma unroll
    for (int p = 0; p < 4; ++p) { const int row = (tid >> 3) + 64 * p, key = kb0 + row; kv[p] = key >= 0 ? *(const u32x4*)(Kb + (size_t)key * 256 + kvh * 64 + (tid & 7) * 8) : (u32x4){0u, 0u, 0u, 0u}; }
#pragma unroll
    for (int p = 0; p < 4; ++p) { const int d = (tid >> 5) + 16 * p, key = kb0 + (tid & 31) * 8; vv[p] = key >= 0 ? *(const u32x4*)(VT + (size_t)(kvh * 64 + d) * T + key) : (u32x4){0u, 0u, 0u, 0u}; }
#pragma unroll
    for (int p = 0; p < 4; ++p) *(LAS u32x4*)(lds + ((tid >> 3) + 64 * p) * AT_KP + (tid & 7) * 16) = kv[p];
#pragma unroll
    for (int p = 0; p < 4; ++p) { LAS unsigned char* dp = lds + AT_VOFF + ((tid >> 5) + 16 * p) * AT_VP + (tid & 31) * 16;
        *(LAS u32x2*)dp = (u32x2){vv[p].x, vv[p].y}; *(LAS u32x2*)(dp + 8) = (u32x2){vv[p].z, vv[p].w}; }
}
__device__ __forceinline__ void attn_task(const Args& A, const LAS unsigned char* lds, int QB, int a, int head, int lane) {
    unsigned char* ws = A.ws;
    const bf16* Q = (const bf16*)(ws + WS_Q); bf16* O = (bf16*)(ws + WS_O);
    const int q0 = QB * 128 + 32 * a, n = lane & 31, hi = lane >> 5;
    bf16x8 qf[4];
    { const bf16* qp = Q + (size_t)(q0 + n) * 1024 + head * 64 + 8 * hi;
#pragma unroll
      for (int ks = 0; ks < 4; ++ks) qf[ks] = *(const bf16x8*)(qp + 16 * ks); }
    f32x16 s[5];
    const float NEG = -1e30f;
#pragma unroll
    for (int kt = 0; kt < 5; ++kt) {
        const int kb = q0 - 128 + 32 * kt;
        f32x16 acc = {0.f, 0.f, 0.f, 0.f, 0.f, 0.f, 0.f, 0.f, 0.f, 0.f, 0.f, 0.f, 0.f, 0.f, 0.f, 0.f};
        if (kb >= 0) { const LAS unsigned char* kp = lds + (32 * (a + kt) + n) * AT_KP + 16 * hi;
#pragma unroll
            for (int ks = 0; ks < 4; ++ks) { const bf16x8 kf = *(const LAS bf16x8*)(kp + 32 * ks); acc = __builtin_amdgcn_mfma_f32_32x32x16_bf16(kf, qf[ks], acc, 0, 0, 0); } }
        MFMA_SETTLE();
#pragma unroll
        for (int i = 0; i < 16; ++i) { const int kl = (i & 3) + 8 * (i >> 2) + 4 * hi;
            bool ok = kb >= 0; if (kt == 0) ok = ok && (kl >= n + 1); if (kt == 4) ok = ok && (kl <= n);
            acc[i] = ok ? acc[i] : NEG; }
        s[kt] = acc;
    }
    float m = NEG;
#pragma unroll
    for (int kt = 0; kt < 5; ++kt)
#pragma unroll
        for (int i = 0; i < 16; ++i) m = fmaxf(m, s[kt][i]);
    m = fmaxf(m, __shfl_xor(m, 32));
    const float sink = ((const float*)A.in[I_SINK])[head];
    m = fmaxf(m, sink);
    float l = 0.f;
#pragma unroll
    for (int kt = 0; kt < 5; ++kt)
#pragma unroll
        for (int i = 0; i < 16; ++i) { const float p = fast_exp(s[kt][i] - m); s[kt][i] = p; l += p; }
    l += __shfl_xor(l, 32);
    const float inv = 1.0f / (l + fast_exp(sink - m));
    f32x16 o[2];
#pragma unroll
    for (int dt = 0; dt < 2; ++dt) o[dt] = (f32x16){0.f, 0.f, 0.f, 0.f, 0.f, 0.f, 0.f, 0.f, 0.f, 0.f, 0.f, 0.f, 0.f, 0.f, 0.f, 0.f};
#pragma unroll
    for (int kt = 0; kt < 5; ++kt) {
        const int kb = q0 - 128 + 32 * kt;
        if (kb >= 0) {
#pragma unroll
            for (int s2 = 0; s2 < 2; ++s2) {
                u32x4 pp; pp.x = pk2(s[kt][8 * s2 + 0] * inv, s[kt][8 * s2 + 1] * inv); pp.y = pk2(s[kt][8 * s2 + 2] * inv, s[kt][8 * s2 + 3] * inv);
                pp.z = pk2(s[kt][8 * s2 + 4] * inv, s[kt][8 * s2 + 5] * inv); pp.w = pk2(s[kt][8 * s2 + 6] * inv, s[kt][8 * s2 + 7] * inv);
                const bf16x8 pf = __builtin_bit_cast(bf16x8, pp);
#pragma unroll
                for (int dt = 0; dt < 2; ++dt) { const LAS unsigned char* vp = lds + AT_VOFF + (dt * 32 + n) * AT_VP + (32 * (a + kt) + 16 * s2 + 4 * hi) * 2;
                    const u32x2 lo = *(const LAS u32x2*)vp, hi8 = *(const LAS u32x2*)(vp + 16);
                    const bf16x8 vf = __builtin_bit_cast(bf16x8, (u32x4){lo.x, lo.y, hi8.x, hi8.y});
                    o[dt] = __builtin_amdgcn_mfma_f32_32x32x16_bf16(pf, vf, o[dt], 0, 0, 0); }
            }
        }
    }
    MFMA_SETTLE();
#pragma unroll
    for (int dt = 0; dt < 2; ++dt)
#pragma unroll
        for (int i = 0; i < 16; ++i) { const int qr = (i & 3) + 8 * (i >> 2) + 4 * hi;
            O[(size_t)(q0 + qr) * 1024 + head * 64 + dt * 32 + n] = (bf16)(pk2(o[dt][i], 0.f) & 0xffffu); }
}

__device__ __forceinline__ void router_block(const Args& A, LAS unsigned char* lds, int tok0, int tid, int wave, int lane) {
    unsigned char* ws = A.ws;
    LAS float* RSTD = (LAS float*)lds; LAS float* PART = (LAS float*)(lds + 1024); LAS float* LOG = (LAS float*)(lds + 1024 + 81920);
    const float* H1 = (const float*)(ws + WS_H1);
#pragma unroll 1
    for (int tt = 0; tt < 4; ++tt) {
        const int tl = 4 * wave + tt;
        const f32x4* hr = (const f32x4*)(H1 + (size_t)(tok0 + tl) * D) + lane; float s = 0.f;
#pragma unroll
        for (int j = 0; j < 8; ++j) { const f32x4 v = hr[64 * j]; s += (v.x * v.x + v.y * v.y) + (v.z * v.z + v.w * v.w); }
        s = wave_sum(s);
        if (lane == 0) RSTD[tl] = 1.0f / sqrtf(s * (1.0f / D) + EPS);
    }
    __syncthreads();
    {
        const int fr = lane & 15, fq = lane >> 4;
        const bf16* WR = (const bf16*)(ws + WS_WR);
        f32x4 acc[5][2];
#pragma unroll
        for (int et = 0; et < 5; ++et)
#pragma unroll
            for (int tt = 0; tt < 2; ++tt) acc[et][tt] = (f32x4){0.f, 0.f, 0.f, 0.f};
        const float rs0 = RSTD[fr], rs1 = RSTD[16 + fr];
#pragma unroll 2
        for (int ks = 0; ks < 8; ++ks) {
            const int k = 256 * wave + 32 * ks + 8 * fq;
            const f32x4 g0 = *(const f32x4*)((const float*)A.in[I_NFG] + k), g1 = *(const f32x4*)((const float*)A.in[I_NFG] + k + 4);
            bf16x8 hh[2], hl[2];
#pragma unroll
            for (int tt = 0; tt < 2; ++tt) {
                const float* hp = H1 + (size_t)(tok0 + tt * 16 + fr) * D + k; const float rs = tt ? rs1 : rs0;
                const f32x4 a = *(const f32x4*)hp * rs * g0, b = *(const f32x4*)(hp + 4) * rs * g1;
                u32x4 hi; hi.x = pk2(a.x, a.y); hi.y = pk2(a.z, a.w); hi.z = pk2(b.x, b.y); hi.w = pk2(b.z, b.w);
                u32x4 lo; lo.x = pk2(a.x - bf_lo(hi.x), a.y - bf_hi(hi.x)); lo.y = pk2(a.z - bf_lo(hi.y), a.w - bf_hi(hi.y)); lo.z = pk2(b.x - bf_lo(hi.z), b.y - bf_hi(hi.z)); lo.w = pk2(b.z - bf_lo(hi.w), b.w - bf_hi(hi.w));
                *(u32x4*)((bf16*)(ws + WS_HN) + (size_t)(tok0 + tt * 16 + fr) * D + k) = hi;
                hh[tt] = __builtin_bit_cast(bf16x8, hi); hl[tt] = __builtin_bit_cast(bf16x8, lo);
            }
#pragma unroll
            for (int et = 0; et < 5; ++et) {
                const bf16x8 wh = *(const bf16x8*)(WR + (size_t)(et * 16 + fr) * D + k), wl = *(const bf16x8*)(WR + (size_t)(80 + et * 16 + fr) * D + k);
#pragma unroll
                for (int tt = 0; tt < 2; ++tt) {
                    acc[et][tt] = __builtin_amdgcn_mfma_f32_16x16x32_bf16(wh, hh[tt], acc[et][tt], 0, 0, 0);
                    acc[et][tt] = __builtin_amdgcn_mfma_f32_16x16x32_bf16(wh, hl[tt], acc[et][tt], 0, 0, 0);
                    acc[et][tt] = __builtin_amdgcn_mfma_f32_16x16x32_bf16(wl, hh[tt], acc[et][tt], 0, 0, 0);
                }
            }
        }
        MFMA_SETTLE();
#pragma unroll
        for (int et = 0; et < 5; ++et)
#pragma unroll
            for (int tt = 0; tt < 2; ++tt)
#pragma unroll
                for (int i = 0; i < 4; ++i) PART[(wave * 80 + et * 16 + 4 * fq + i) * 32 + tt * 16 + fr] = acc[et][tt][i];
    }
    __syncthreads();
    for (int i = tid; i < 72 * 32; i += NWAVES * 64) { const int o = i >> 5, t = i & 31;
        const float b = o < 64 ? ((const float*)A.in[I_BRE2])[o] : ((const float*)A.in[I_BRG])[o - 64];
        float s = 0.f;
#pragma unroll
        for (int w = 0; w < 8; ++w) s += PART[(w * 80 + o) * 32 + t];
        LOG[t * 72 + o] = s + b; }
    __syncthreads();
    if (tid < 32) {
        const int t = tok0 + tid; const LAS float* lg = LOG + tid * 72;
        float gb = lg[64]; int gi = 0;
#pragma unroll
        for (int j = 1; j < 8; ++j) { const float v = lg[64 + j]; if (v > gb) { gb = v; gi = j; } }
        float se = 0.f;
#pragma unroll
        for (int j = 0; j < 8; ++j) se += expf(lg[64 + j] - gb);
        const float pgrp = 1.0f / se;
        const LAS float* le = lg + gi * 8;
        float b0 = le[0]; int i0 = 0;
#pragma unroll
        for (int j = 1; j < 8; ++j) { const float v = le[j]; if (v > b0) { b0 = v; i0 = j; } }
        float b1 = -3.0e38f; int i1 = 0;
#pragma unroll
        for (int j = 0; j < 8; ++j) { const float v = le[j]; if (j != i0 && v > b1) { b1 = v; i1 = j; } }
        const float ex = expf(b1 - b0), w0 = 1.0f / (1.0f + ex), w1 = ex * w0;
        unsigned* cnt = (unsigned*)(ws + WS_CTL) + CW_CNT;
        const int e0 = gi * 8 + i0, e1 = gi * 8 + i1;
        const unsigned sl0 = __hip_atomic_fetch_add(cnt + e0, 1u, __ATOMIC_RELAXED, __HIP_MEMORY_SCOPE_AGENT);
        const unsigned sl1 = __hip_atomic_fetch_add(cnt + e1, 1u, __ATOMIC_RELAXED, __HIP_MEMORY_SCOPE_AGENT);
        ((int*)(ws + WS_LISTA))[e0 * LIST_CAP + sl0] = 2 * t;     ((float*)(ws + WS_LISTW))[e0 * LIST_CAP + sl0] = w0 * pgrp;
        ((int*)(ws + WS_LISTA))[e1 * LIST_CAP + sl1] = 2 * t + 1; ((float*)(ws + WS_LISTW))[e1 * LIST_CAP + sl1] = w1 * pgrp;
    }
    __syncthreads();
}

__device__ __forceinline__ void final_rows(const Args& A, int gw, int NGW, int lane) {
    unsigned char* ws = A.ws;
    const f32x4* gp = (const f32x4*)A.in[I_NFIN] + lane;
    for (int m = gw; m < T; m += NGW) {
        const f32x4* hr = (const f32x4*)((const float*)(ws + WS_H1) + (size_t)m * D) + lane;
        const u32x2* y0 = (const u32x2*)((const bf16*)(ws + WS_Y2) + (size_t)(2 * m) * D) + lane; const u32x2* y1 = (const u32x2*)((const bf16*)(ws + WS_Y2) + (size_t)(2 * m + 1) * D) + lane;
        f32x4 v[8]; float s = 0.f;
#pragma unroll
        for (int j = 0; j < 8; ++j) { const u32x2 a = y0[64 * j], b = y1[64 * j]; f32x4 h = hr[64 * j];
            h.x += bf_lo(a.x) + bf_lo(b.x); h.y += bf_hi(a.x) + bf_hi(b.x); h.z += bf_lo(a.y) + bf_lo(b.y); h.w += bf_hi(a.y) + bf_hi(b.y);
            v[j] = h; s += (h.x * h.x + h.y * h.y) + (h.z * h.z + h.w * h.w); }
        const float rstd = 1.0f / sqrtf(wave_sum(s) * (1.0f / D) + EPS);
        f32x4* o = (f32x4*)(A.out + (size_t)m * D) + lane;
#pragma unroll
        for (int j = 0; j < 8; ++j) o[64 * j] = v[j] * rstd * gp[64 * j];
    }
}

__global__ void __launch_bounds__(NWAVES * 64, 2) mega_fwd(Args args) {
    extern __shared__ __attribute__((aligned(16))) unsigned char lds_raw[];
    LAS unsigned char* lds = (LAS unsigned char*)lds_raw;
    volatile LAS unsigned* MISC = (volatile LAS unsigned*)(lds + MISC_OFF);
    const int tid = threadIdx.x, lane = tid & 63, wave = __builtin_amdgcn_readfirstlane(tid >> 6);
    const int G = gridDim.x, bx = blockIdx.x;
    const int vcu = (G % 8 == 0) ? (bx % 8) * (G / 8) + bx / 8 : bx;
    const int gw = vcu * NWAVES + wave, NGW = G * NWAVES;
    unsigned char* ws = args.ws;
    unsigned* ctl = (unsigned*)(ws + WS_CTL);
    for (int u = tid; u < 256; u += NWAVES * 64) MISC[u] = 0u;
    __syncthreads();
    XcdBarrier bar; bar.bar = ctl + CW_BAR; bar.x = 0; bar.st = nullptr;
    if (N_LAUNCHES == 1) bar = xcd_barrier_post(ctl + CW_BAR, MISC + 8);
    const int lo = args.ph_lo, hi = args.ph_hi;
#define IN(k) (((PHMASK >> (k)) & 1) && lo <= (k) && (k) < hi)
#define SEAM(k) do { if (IN(k) && IN((k) + 1)) xcd_barrier(bar); } while (0)

    if (IN(0)) REP(0) { p0_prologue(args, lds, gw, NGW, wave, lane); }
    SEAM(0);
    if (IN(1)) REP(1) {
        SchedP1 S{(const char*)(ws + WS_XN), (const char*)(ws + WS_WIN), G, bx};
        EpiP1 E{(bf16*)(ws + WS_U), (bf16*)(ws + WS_Q), (bf16*)(ws + WS_K), (bf16*)(ws + WS_VT), (bf16*)(ws + WS_GATES), (const float*)args.in[I_BIN], (const int*)args.in[I_POS]};
        pg8::gemm_phase<EpiP1, SchedP1, true, true, false>(lds, D, S, E);
        if (G == 256 ? bx >= 64 : true) { const int nb_ = G == 256 ? 192 : G, ib_ = G == 256 ? bx - 64 : bx; convert_later_weights(args, lds, ib_ * NWAVES + wave, nb_ * NWAVES, wave, lane); p0_tables(args, ib_ * NWAVES + wave, nb_ * NWAVES, lane); }
    }
    SEAM(1);
    if (IN(2)) REP(2) {
        for (int task = vcu; task < 256; task += G) ssm_task<false>(args, (task >> 5) * 8 + wave, task & 31, (task & 31) + 32, lds + wave * 16384, lane);
        for (int unit = vcu; unit < 256; unit += G) { const int QB = unit >> 2, kvh = unit & 3;
            __syncthreads();
            attn_stage(args, lds, QB, kvh, tid);
            __syncthreads();
#pragma unroll 1
            for (int r = 0; r < 2; ++r) { const int tk = wave + 8 * r; attn_task(args, lds, QB, tk & 3, kvh * 4 + (tk >> 2), lane); } }
    }
    SEAM(2);
    if (IN(3)) REP(3) { for (int task = vcu; task < 256; task += G) ssm_task<true>(args, (task >> 5) * 8 + wave, task & 31, (task & 31) + 32, lds + wave * 16384, lane); }
    SEAM(3);
    if (IN(4)) REP(4) {
        SchedGrid S{(const char*)(ws + WS_Z), (const char*)(ws + WS_WGLU), nullptr, nullptr, 32, 8, 1, 1024, G, bx};
        EpiGlu E{(bf16*)(ws + WS_G), (const float*)args.in[I_BGLU]};
        pg8::gemm_phase<EpiGlu, SchedGrid, true, true, false>(lds, 1024, S, E);
    }
    SEAM(4);
    if (IN(5)) REP(5) {
        if (G == 256) {
            SchedGrid S{(const char*)(ws + WS_G), (const char*)(ws + WS_WBRS), (const char*)(ws + WS_O), (const char*)(ws + WS_WBRA), 32, 8, 2, 1024, G, bx};
            EpiMix E{(bf16*)(ws + WS_MIX), (const bf16*)(ws + WS_GATES)};
            pg8::gemm_phase<EpiMix, SchedGrid, true, true, false>(lds, 1024, S, E);
        }
    }
    SEAM(5);
    if (IN(6)) REP(6) {
        SchedGrid S{(const char*)(ws + WS_MIX), (const char*)(ws + WS_WO), nullptr, nullptr, 32, 8, 1, 2048, G, bx};
        EpiRes E{(const float*)args.in[I_X], (float*)(ws + WS_H1)};
        pg8::gemm_phase<EpiRes, SchedGrid, true, true, false>(lds, 2048, S, E);
    }
    SEAM(6);
    if (IN(7)) { for (int tb = vcu; tb < T / 32; tb += G) router_block(args, lds, tb * 32, tid, wave, lane); }
    SEAM(7);
    if (IN(8) || IN(9)) {
        const int* cnt = (const int*)(ctl + CW_CNT);
        if (tid < 64) MISC[96 + tid] = (unsigned)((cnt[tid] + moe::BM - 1) / moe::BM);
        __syncthreads();
        if (tid == 0) { unsigned acc = 0; for (int e = 0; e < 64; ++e) { MISC[16 + e] = acc; acc += MISC[96 + e]; } MISC[16 + 64] = acc; }
        __syncthreads();
        const volatile LAS int* pref = (const volatile LAS int*)(MISC + 16);
        if (IN(8)) REP(8) moe::gemm<true>(lds, args, pref, G, bx);
        SEAM(8);
        if (IN(9)) REP(9) moe::gemm<false>(lds, args, pref, G, bx);
    }
    SEAM(9);
    if (IN(10)) REP(10) final_rows(args, gw, NGW, lane);
#undef IN
#undef SEAM
}

extern "C" void kernel_launch(void* const* d_in, const int* in_sizes, int n_in, void* d_out, int out_size, void* d_ws, size_t ws_size, hipStream_t stream) {
    static int grid = 0;
    if (grid == 0) {
        if (n_in != 28 || out_size != T * D || ws_size < WS_END) { fprintf(stderr, "kernel_launch: expected 28 inputs, %d outputs, >= %zu bytes of workspace; got %d, %d, %zu\n", T * D, (size_t)WS_END, n_in, out_size, ws_size); grid = -1; return; }
        int dev = 0, cus = 0, per_cu = 0;
        if (hipGetDevice(&dev) != hipSuccess || hipDeviceGetAttribute(&cus, hipDeviceAttributeMultiprocessorCount, dev) != hipSuccess) { grid = -1; return; }
        if (hipFuncSetAttribute((const void*)mega_fwd, hipFuncAttributeMaxDynamicSharedMemorySize, LDS_BYTES) != hipSuccess) { fprintf(stderr, "kernel_launch: hipFuncSetAttribute failed\n"); grid = -1; return; }
        if (hipOccupancyMaxActiveBlocksPerMultiprocessor(&per_cu, (const void*)mega_fwd, NWAVES * 64, LDS_BYTES) != hipSuccess || per_cu < 1) fprintf(stderr, "kernel_launch: occupancy query reports %d workgroups per CU\n", per_cu);
        (void)hipGetLastError();
        grid = cus;
        if (grid != 256) fprintf(stderr, "kernel_launch: %d CUs; built for 256\n", grid);
    }
    if (grid < 0) return;
    if (hipMemsetAsync((char*)d_ws + WS_CTL, 0, CTL_ZERO_BYTES, stream) != hipSuccess) { fprintf(stderr, "kernel_launch: hipMemsetAsync failed\n"); return; }
    Args a{};
    for (int i = 0; i < 28; ++i) a.in[i] = d_in[i];
    a.out = (float*)d_out; a.ws = (unsigned char*)d_ws;
    for (int li = 0; li < N_LAUNCHES; ++li) {
        a.ph_lo = (N_LAUNCHES == 1) ? 0 : li; a.ph_hi = (N_LAUNCHES == 1) ? N_PHASES : li + 1;
        hipLaunchKernelGGL(mega_fwd, dim3(grid), dim3(NWAVES * 64), LDS_BYTES, stream, a);
        const hipError_t le = hipPeekAtLastError();
        if (le != hipSuccess) { fprintf(stderr, "kernel_launch: launch %d failed: %s\n", li, hipGetErrorName(le)); break; }
    }
}
```
